# Optimizing an MI355X kernel written in HIP

```python
import jax, jax.numpy as jnp
from jax import lax
import numpy as np

D_MODEL = 1024
BATCH = 2
SEQ = 8192
DEPTH = 2

GRID_W = 64
CTX_LEN = 256
HEAD_DIM = 64
BLOCK = 128
WINDOW = 128
A_HEADS = 4
A_KV_HEADS = 2
B_HEADS = 4
B_KV_HEADS = 2
C_HEADS = 8
C_Q_RANK = 256
C_KV_RANK = 128
C_NOPE_DIM = 64
C_ROPE_DIM = 32
C_V_DIM = 64
D_MIX = (A_HEADS + B_HEADS) * HEAD_DIM + C_HEADS * C_V_DIM
D_FF = 4 * D_MODEL
ROPE_THETA = 10000.0
NORM_EPS = 1e-6
NEG_INF = -1e30
DEEPNORM_ALPHA = (2 * DEPTH) ** 0.25
DEEPNORM_BETA = (8 * DEPTH) ** -0.25
IN_SPLITS = (A_HEADS * HEAD_DIM, A_KV_HEADS * HEAD_DIM, A_KV_HEADS * HEAD_DIM,
             B_HEADS * HEAD_DIM, B_KV_HEADS * HEAD_DIM, B_KV_HEADS * HEAD_DIM,
             C_Q_RANK, C_KV_RANK, C_ROPE_DIM)
IN_OFFSETS = tuple(int(o) for o in np.cumsum(IN_SPLITS)[:-1])
D_IN = int(sum(IN_SPLITS))

kernel_name = "hymba_style_hybrid_dit_block"

F32 = jnp.float32


def _rms_norm(x, g):
    xf = x.astype(F32)
    y = xf * lax.rsqrt(jnp.mean(xf * xf, axis=-1, keepdims=True) + NORM_EPS)
    return (y * g.astype(F32)).astype(x.dtype)


def _layer_norm(x, g, b):
    xf = x.astype(F32)
    mu = jnp.mean(xf, axis=-1, keepdims=True)
    var = jnp.mean(jnp.square(xf - mu), axis=-1, keepdims=True)
    y = (xf - mu) * lax.rsqrt(var + NORM_EPS) * g.astype(F32) + b.astype(F32)
    return y.astype(x.dtype)


def _axial_rope_tables(n_rows, rot_dim):
    row = jnp.repeat(jnp.arange(n_rows, dtype=F32), GRID_W)
    col = jnp.tile(jnp.arange(GRID_W, dtype=F32), n_rows)
    n_freq = rot_dim // 4
    inv = ROPE_THETA ** (-jnp.arange(n_freq, dtype=F32) / n_freq)
    ang = jnp.concatenate([row[:, None] * inv, col[:, None] * inv], axis=-1)
    return jnp.cos(ang), jnp.sin(ang)


def _apply_rope(x, cos, sin):
    half = x.shape[-1] // 2
    xf = x.astype(F32)
    x1, x2 = xf[..., :half], xf[..., half:]
    c, s = cos[None, :, None, :], sin[None, :, None, :]
    return jnp.concatenate([x1 * c - x2 * s, x1 * s + x2 * c], axis=-1).astype(x.dtype)


def _heads(t, n_heads):
    return t.reshape(t.shape[0], t.shape[1], n_heads, t.shape[-1] // n_heads)


def _merge(t):
    return t.reshape(t.shape[0], t.shape[1], -1)


def _gqa_core(q, k, v, sink=None):
    bsz, n_q, n_h, dh = q.shape
    n_kv = k.shape[2]
    grp = n_h // n_kv
    n_keys = k.shape[1]
    qg = q.reshape(bsz, n_q, n_kv, grp, dh)
    s = jnp.einsum('bqkgd,bskd->bkgqs', qg, k).astype(F32) * (dh ** -0.5)
    if sink is not None:
        sink_logit = jnp.broadcast_to(sink.astype(F32).reshape(n_kv, grp)[None, :, :, None, None], s.shape[:-1] + (1,))
        s = jnp.concatenate([s, sink_logit], axis=-1)
    p = jax.nn.softmax(s, axis=-1)[..., :n_keys].astype(v.dtype)
    out = jnp.einsum('bkgqs,bskd->bqkgd', p, v)
    return out.reshape(bsz, n_q, n_h, dh)


def _mla_core(q_nope, q_rope, k_nope, k_rope, v):
    scale = (C_NOPE_DIM + C_ROPE_DIM) ** -0.5
    s = jnp.einsum('bqhd,bshd->bhqs', q_nope, k_nope) + jnp.einsum('bqhr,bsr->bhqs', q_rope, k_rope)
    p = jax.nn.softmax(s.astype(F32) * scale, axis=-1).astype(v.dtype)
    return jnp.einsum('bhqs,bshd->bqhd', p, v)


def _sweep_query_blocks(fn, qs):
    nb = qs[0].shape[1] // BLOCK
    to_blocks = lambda t: jnp.moveaxis(t.reshape(t.shape[0], nb, BLOCK, *t.shape[2:]), 1, 0)
    out = lax.map(lambda qb: fn(*qb), tuple(to_blocks(t) for t in qs))
    out = jnp.moveaxis(out, 0, 1)
    return out.reshape(out.shape[0], nb * BLOCK, *out.shape[3:])


def _window_attn(q, k, v, k_ctx, v_ctx, sink):
    bsz, n_tok, n_h, dh = q.shape
    n_kv = k.shape[2]
    grp = n_h // n_kv
    nb = n_tok // BLOCK
    n_loc, n_ctx = 3 * BLOCK, k_ctx.shape[1]
    scale = dh ** -0.5
    qb = q.reshape(bsz, nb, BLOCK, n_kv, grp, dh)
    pad = ((0, 0), (BLOCK, BLOCK), (0, 0), (0, 0))
    band = (jnp.arange(nb) * BLOCK)[:, None] + jnp.arange(n_loc)[None, :]
    kb = jnp.pad(k, pad)[:, band]
    vb = jnp.pad(v, pad)[:, band]
    s_loc = jnp.einsum('bnqkgd,bnskd->bnkgqs', qb, kb).astype(F32) * scale
    s_ctx = jnp.einsum('bnqkgd,bckd->bnkgqc', qb, k_ctx).astype(F32) * scale
    q_pos = (jnp.arange(nb) * BLOCK)[:, None] + jnp.arange(BLOCK)[None, :]
    k_pos = band - BLOCK
    rel = k_pos[:, None, :] - q_pos[:, :, None]
    valid = (jnp.abs(rel) <= WINDOW) & (k_pos[:, None, :] >= 0) & (k_pos[:, None, :] < n_tok)
    s_loc = jnp.where(valid[None, :, None, None], s_loc, NEG_INF)
    sink_logit = jnp.broadcast_to(sink.astype(F32).reshape(n_kv, grp)[None, None, :, :, None, None], s_loc.shape[:-1] + (1,))
    p = jax.nn.softmax(jnp.concatenate([s_loc, s_ctx, sink_logit], axis=-1), axis=-1).astype(v.dtype)
    out = (jnp.einsum('bnkgqs,bnskd->bnqkgd', p[..., :n_loc], vb)
           + jnp.einsum('bnkgqc,bckd->bnqkgd', p[..., n_loc:n_loc + n_ctx], v_ctx))
    return out.reshape(bsz, n_tok, n_h, dh)


def _token_mixers(h, hc, w_in, sink_a, q_norm_b, k_norm_b, mla_q_norm, mla_kv_norm,
                  w_uq, w_uk, w_uv, w_out, rope64, rope32, with_ctx_out):
    cos64, sin64 = rope64
    cos32, sin32 = rope32
    a_q, a_k, a_v, b_q, b_k, b_v, c_q, c_kv, c_kr = jnp.split(h @ w_in, IN_OFFSETS, axis=-1)
    a_qc, a_kc, a_vc, b_qc, b_kc, b_vc, c_qc, c_kvc, c_krc = jnp.split(hc @ w_in, IN_OFFSETS, axis=-1)

    q_a = _apply_rope(_heads(a_q, A_HEADS), cos64, sin64)
    k_a = _apply_rope(_heads(a_k, A_KV_HEADS), cos64, sin64)
    v_a = _heads(a_v, A_KV_HEADS)
    k_a_ctx, v_a_ctx = _heads(a_kc, A_KV_HEADS), _heads(a_vc, A_KV_HEADS)
    y_a = _window_attn(q_a, k_a, v_a, k_a_ctx, v_a_ctx, sink_a)

    q_b = _apply_rope(_rms_norm(_heads(b_q, B_HEADS), q_norm_b), cos64, sin64)
    k_b = _apply_rope(_rms_norm(_heads(b_k, B_KV_HEADS), k_norm_b), cos64, sin64)
    v_b = _heads(b_v, B_KV_HEADS)
    k_b_ctx = _rms_norm(_heads(b_kc, B_KV_HEADS), k_norm_b)
    v_b_ctx = _heads(b_vc, B_KV_HEADS)
    k_b_all = jnp.concatenate([k_b_ctx, k_b], axis=1)
    v_b_all = jnp.concatenate([v_b_ctx, v_b], axis=1)
    y_b = _sweep_query_blocks(lambda qi: _gqa_core(qi, k_b_all, v_b_all), (q_b,))

    def mla_q(cq):
        q = _heads(_rms_norm(cq, mla_q_norm) @ w_uq, C_HEADS)
        return q[..., :C_NOPE_DIM], q[..., C_NOPE_DIM:]

    def mla_kv(ckv):
        ckv = _rms_norm(ckv, mla_kv_norm)
        return _heads(ckv @ w_uk, C_HEADS), _heads(ckv @ w_uv, C_HEADS)

    q_c_nope, q_c_rope = mla_q(c_q)
    q_c_rope = _apply_rope(q_c_rope, cos32, sin32)
    k_c_nope, v_c = mla_kv(c_kv)
    k_c_rope = _apply_rope(c_kr[:, :, None, :], cos32, sin32)[:, :, 0, :]
    k_c_nope_ctx, v_c_ctx = mla_kv(c_kvc)
    k_c_nope_all = jnp.concatenate([k_c_nope_ctx, k_c_nope], axis=1)
    k_c_rope_all = jnp.concatenate([c_krc, k_c_rope], axis=1)
    v_c_all = jnp.concatenate([v_c_ctx, v_c], axis=1)
    y_c = _sweep_query_blocks(lambda qn, qr: _mla_core(qn, qr, k_c_nope_all, k_c_rope_all, v_c_all),
                              (q_c_nope, q_c_rope))

    y = jnp.concatenate([_merge(y_a), _merge(y_b), _merge(y_c)], axis=-1) @ w_out
    if not with_ctx_out:
        return y, None

    yc_a = _gqa_core(_heads(a_qc, A_HEADS), k_a_ctx, v_a_ctx, sink_a)
    yc_b = _gqa_core(_rms_norm(_heads(b_qc, B_HEADS), q_norm_b), k_b_ctx, v_b_ctx)
    qc_nope, qc_rope = mla_q(c_qc)
    yc_c = _mla_core(qc_nope, qc_rope, k_c_nope_ctx, c_krc, v_c_ctx)
    yc = jnp.concatenate([_merge(yc_a), _merge(yc_b), _merge(yc_c)], axis=-1) @ w_out
    return y, yc


def _sq_relu_mlp(h, w1, w2):
    a = jnp.maximum(h @ w1, 0)
    return (a * a) @ w2


def setup_inputs(seed: int = 0) -> dict:
    key = jax.random.key(seed)
    ks = iter(jax.random.split(key, 32))
    nrm = lambda shape, scale: jax.random.normal(next(ks), shape, F32) * scale
    gain = lambda shape: 1.0 + nrm(shape, 0.02)
    L = DEPTH
    return {
        "x": nrm((BATCH, SEQ, D_MODEL), 1.0),
        "c": nrm((BATCH, D_MODEL), 1.0),
        "ctx": nrm((BATCH, CTX_LEN, D_MODEL), 1.0),
        "c_ctx": nrm((D_MODEL,), 1.0),
        "w_mod": nrm((L, D_MODEL, 6 * D_MODEL), 0.5 * D_MODEL ** -0.5),
        "b_mod": nrm((L, 6 * D_MODEL), 0.01),
        "w_in": nrm((L, D_MODEL, D_IN), D_MODEL ** -0.5),
        "sink_a": nrm((L, A_HEADS), 0.5),
        "q_norm_b": gain((L, HEAD_DIM)),
        "k_norm_b": gain((L, HEAD_DIM)),
        "mla_q_norm": gain((L, C_Q_RANK)),
        "mla_kv_norm": gain((L, C_KV_RANK)),
        "w_uq": nrm((L, C_Q_RANK, C_HEADS * (C_NOPE_DIM + C_ROPE_DIM)), C_Q_RANK ** -0.5),
        "w_uk": nrm((L, C_KV_RANK, C_HEADS * C_NOPE_DIM), C_KV_RANK ** -0.5),
        "w_uv": nrm((L, C_KV_RANK, C_HEADS * C_V_DIM), C_KV_RANK ** -0.5),
        "w_out": nrm((L, D_MIX, D_MODEL), DEEPNORM_BETA * D_MIX ** -0.5),
        "ln1_g": gain((L, D_MODEL)),
        "ln1_b": nrm((L, D_MODEL), 0.02),
        "w_fc1": nrm((L, D_MODEL, D_FF), D_MODEL ** -0.5),
        "w_fc2": nrm((L, D_FF, D_MODEL), DEEPNORM_BETA * D_FF ** -0.5),
        "ln2_g": gain((L, D_MODEL)),
        "ln2_b": nrm((L, D_MODEL), 0.02),
    }


def reference(x, c, ctx, c_ctx, w_mod, b_mod, w_in, sink_a, q_norm_b, k_norm_b, mla_q_norm, mla_kv_norm,
              w_uq, w_uk, w_uv, w_out, ln1_g, ln1_b, w_fc1, w_fc2, ln2_g, ln2_b):
    n_rows = x.shape[1] // GRID_W
    rope64 = _axial_rope_tables(n_rows, HEAD_DIM)
    rope32 = _axial_rope_tables(n_rows, C_ROPE_DIM)
    xc = ctx
    for l in range(DEPTH):
        last = l == DEPTH - 1
        mod = jax.nn.silu(c) @ w_mod[l] + b_mod[l]
        mod_c = jax.nn.silu(c_ctx) @ w_mod[l] + b_mod[l]
        sh1, sc1, g1, sh2, sc2, g2 = jnp.split(mod[:, None, :], 6, axis=-1)
        sh1c, sc1c, g1c, sh2c, sc2c, g2c = jnp.split(mod_c, 6, axis=-1)

        h = x * (1 + sc1) + sh1
        hc = xc * (1 + sc1c) + sh1c
        y, yc = _token_mixers(h, hc, w_in[l], sink_a[l], q_norm_b[l], k_norm_b[l], mla_q_norm[l], mla_kv_norm[l],
                              w_uq[l], w_uk[l], w_uv[l], w_out[l], rope64, rope32, not last)
        x = _layer_norm(DEEPNORM_ALPHA * x + g1 * y, ln1_g[l], ln1_b[l])

        h = x * (1 + sc2) + sh2
        x = _layer_norm(DEEPNORM_ALPHA * x + g2 * _sq_relu_mlp(h, w_fc1[l], w_fc2[l]), ln2_g[l], ln2_b[l])

        if not last:
            xc = _layer_norm(DEEPNORM_ALPHA * xc + g1c * yc, ln1_g[l], ln1_b[l])
            hc = xc * (1 + sc2c) + sh2c
            xc = _layer_norm(DEEPNORM_ALPHA * xc + g2c * _sq_relu_mlp(hc, w_fc1[l], w_fc2[l]), ln2_g[l], ln2_b[l])
    return x
```

```cpp
#include <hip/hip_runtime.h>
#include <hip/hip_cooperative_groups.h>
#include <cstdio>
#include <cstdint>
namespace cg = cooperative_groups;

constexpr int D = 1024, NB = 2, SEQ = 8192, CTX = 256, DEPTH = 2;
constexpr int ML = NB * SEQ, MC = NB * CTX, MA = ML + MC;
constexpr int DIN = 1440, DFF = 4096, DMOD = 6 * D;
constexpr int KROWS = CTX + SEQ, NTILE = KROWS / 64;
constexpr float LN_EPS = 1e-6f, RMS_EPS = 1e-6f;
constexpr float ALPHA = 1.41421356237309515f;
constexpr float LOG2E = 1.4426950408889634f;
constexpr float C2AB = 0.125f * LOG2E;
constexpr float C2C = 0.10206207261596577f * LOG2E;
constexpr int NTHREADS = 512;

typedef unsigned short bf16;

constexpr size_t MiB = 1u << 20;
constexpr size_t al(size_t x) { return (x + 255) & ~(size_t)255; }
constexpr size_t WS_CTL = 0;
constexpr size_t WS_MOD = 1 * MiB;
constexpr size_t WS_T64 = WS_MOD + al((size_t)DEPTH * 3 * DMOD * 4);
constexpr size_t WS_T32 = WS_T64 + al(128 * 16 * 8);
constexpr size_t WS_SSQ = WS_T32 + al(128 * 8 * 8);
constexpr size_t WS_RC = WS_SSQ + al((size_t)MA * 8 * 4);
constexpr size_t WS_H = WS_RC + al((size_t)MC * D * 4);
constexpr size_t WS_W = WS_H + al((size_t)MA * D * 2);
constexpr size_t W_IN = 0, W_UP = W_IN + (size_t)1536 * 1024 * 2, W_OUT = W_UP + (size_t)1792 * 256 * 2,
                 W_FC1 = W_OUT + (size_t)1024 * 1024 * 2, W_FC2 = W_FC1 + (size_t)4096 * 1024 * 2, W_LAYER = W_FC2 + (size_t)4096 * 1024 * 2;
constexpr size_t WS_R = WS_W + al(DEPTH * W_LAYER);
constexpr size_t R_QA = 0, R_QB = R_QA + (size_t)MA * 256 * 2, R_QC = R_QB + (size_t)MA * 256 * 2, R_AUP = R_QC + (size_t)MA * 768 * 2,
                 R_KA = R_AUP + (size_t)MA * 512 * 2, IMG64 = (size_t)NTILE * 4096 * 2  ,
                 R_VA = R_KA + 4 * IMG64, R_KB = R_VA + 4 * IMG64, R_VB = R_KB + 4 * IMG64, R_KC = R_VB + 4 * IMG64, R_VC = R_KC + 16 * IMG64,
                 R_KR = R_VC + 16 * IMG64, R_Y = R_KR + 2 * IMG64 / 2, R_END = R_Y + (size_t)MA * D * 2;
constexpr size_t R_HID = 0;
static_assert((size_t)MA * DFF * 2 <= R_END, "hid overlay");
constexpr size_t WS_END = WS_R + R_END;
static_assert(WS_END <= 256 * MiB, "workspace");

struct Params {
    const float *x, *c, *ctx, *c_ctx, *w_mod, *b_mod, *w_in, *sink_a, *q_norm_b, *k_norm_b, *mla_q_norm, *mla_kv_norm,
        *w_uq, *w_uk, *w_uv, *w_out, *ln1_g, *ln1_b, *w_fc1, *w_fc2, *ln2_g, *ln2_b;
    float* out; unsigned char* ws;
};

__device__ __forceinline__ unsigned f2bf(float f) { unsigned u = __builtin_bit_cast(unsigned, f); return (u + 0x7fffu + ((u >> 16) & 1u)) >> 16; }
__device__ __forceinline__ float bf2f(unsigned h) { return __builtin_bit_cast(float, h << 16); }
__device__ __forceinline__ float wave_sum(float v) {
#pragma unroll
    for (int o = 1; o < 64; o <<= 1) v += __shfl_xor(v, o);
    return v;
}
__device__ __forceinline__ size_t kimg(int krow, int d) { return ((size_t)((krow >> 6) * 8 + (d >> 3)) * 64 + (krow & 63)) * 8 + (d & 7); }
__device__ __forceinline__ size_t krimg(int krow, int d) { return ((size_t)((krow >> 6) * 4 + (d >> 3)) * 64 + (krow & 63)) * 8 + (d & 7); }
__device__ __forceinline__ size_t vimg(int krow, int d) { const int rr = krow & 63; return (size_t)(krow >> 6) * 4096 + (d >> 5) * 2048 + (rr >> 4) * 512 + (rr & 15) * 32 + (d & 31); }
struct RowInfo { int b, krow, set, t; bool lat; };
__device__ __forceinline__ RowInfo row_info(int r) {
    RowInfo ri;
    if (r < ML) { ri.b = r >> 13; ri.t = r & (SEQ - 1); ri.krow = CTX + ri.t; ri.set = ri.b; ri.lat = true; }
    else { const int j = r - ML; ri.b = j >> 8; ri.t = 0; ri.krow = j & 255; ri.set = 2; ri.lat = false; }
    return ri;
}
struct Ctx {
    Params p; int layer;
    float* MOD; float2* T64; float2* T32; float* SSQ; float* RC; bf16* H; unsigned char* R;
    __device__ __forceinline__ const float* mod(int set, int which) const { return MOD + ((size_t)(layer * 3 + set) * 6 + which) * D; }
    __device__ __forceinline__ const float* resid_in(int r) const {
        if (layer == 0) return r < ML ? p.x + (size_t)r * D : p.ctx + (size_t)(r - ML) * D;
        return r < ML ? p.out + (size_t)r * D : RC + (size_t)(r - ML) * D; }
    __device__ __forceinline__ float* resid(int r) const { return r < ML ? p.out + (size_t)r * D : RC + (size_t)(r - ML) * D; }
    __device__ __forceinline__ bf16* QA() const { return (bf16*)(R + R_QA); }
    __device__ __forceinline__ bf16* QB() const { return (bf16*)(R + R_QB); }
    __device__ __forceinline__ bf16* QC() const { return (bf16*)(R + R_QC); }
    __device__ __forceinline__ bf16* AUP() const { return (bf16*)(R + R_AUP); }
    __device__ __forceinline__ bf16* KA(int b, int kv) const { return (bf16*)(R + R_KA + (size_t)(b * 2 + kv) * IMG64); }
    __device__ __forceinline__ bf16* VA(int b, int kv) const { return (bf16*)(R + R_VA + (size_t)(b * 2 + kv) * IMG64); }
    __device__ __forceinline__ bf16* KB(int b, int kv) const { return (bf16*)(R + R_KB + (size_t)(b * 2 + kv) * IMG64); }
    __device__ __forceinline__ bf16* VB(int b, int kv) const { return (bf16*)(R + R_VB + (size_t)(b * 2 + kv) * IMG64); }
    __device__ __forceinline__ bf16* KC(int b, int h) const { return (bf16*)(R + R_KC + (size_t)(b * 8 + h) * IMG64); }
    __device__ __forceinline__ bf16* VC(int b, int h) const { return (bf16*)(R + R_VC + (size_t)(b * 8 + h) * IMG64); }
    __device__ __forceinline__ bf16* KR(int b) const { return (bf16*)(R + R_KR + (size_t)b * (IMG64 / 2)); }
    __device__ __forceinline__ bf16* Y() const { return (bf16*)(R + R_Y); }
    __device__ __forceinline__ bf16* HID() const { return (bf16*)(R + R_HID); }
};

namespace nv {
__device__ __forceinline__ float silu(float v) { return v / (1.f + expf(-v)); }

__device__ void ph_mod_tables(const Ctx& C, int gtid, int gsz) {
    for (int idx = gtid; idx < DEPTH * 3 * DMOD; idx += gsz) {
        const int l = idx / (3 * DMOD), s = (idx / DMOD) % 3, n = idx % DMOD;
        const float* cv = s < 2 ? C.p.c + s * D : C.p.c_ctx;
        const float* w = C.p.w_mod + (size_t)l * D * DMOD + n;
        float acc = C.p.b_mod[l * DMOD + n];
        for (int k = 0; k < D; ++k) acc += silu(cv[k]) * w[(size_t)k * DMOD];
        C.MOD[idx] = acc;
    }
    for (int idx = gtid; idx < 128 * 16; idx += gsz) { const int pos = idx >> 4, j = idx & 15; const float inv = powf(10000.f, -(float)j / 16.f), a = (float)pos * inv; C.T64[idx] = make_float2(cosf(a), sinf(a)); }
    for (int idx = gtid; idx < 128 * 8; idx += gsz) { const int pos = idx >> 3, j = idx & 7; const float inv = powf(10000.f, -(float)j / 8.f), a = (float)pos * inv; C.T32[idx] = make_float2(cosf(a), sinf(a)); }
}
__device__ void ph_modulate(const Ctx& C, int gtid, int gsz, int nrows) {
    for (size_t idx = gtid; idx < (size_t)nrows * (D / 4); idx += gsz) {
        const int r = (int)(idx / (D / 4)), c4 = (int)(idx % (D / 4)) * 4; const RowInfo ri = row_info(r);
        const float4 v = *(const float4*)(C.resid_in(r) + c4); const float4 sc = *(const float4*)(C.mod(ri.set, 1) + c4), sh = *(const float4*)(C.mod(ri.set, 0) + c4);
        ushort4 o; o.x = f2bf(v.x * (1.f + sc.x) + sh.x); o.y = f2bf(v.y * (1.f + sc.y) + sh.y); o.z = f2bf(v.z * (1.f + sc.z) + sh.z); o.w = f2bf(v.w * (1.f + sc.w) + sh.w);
        *(ushort4*)(C.H + (size_t)r * D + c4) = o;
    }
}
__device__ __forceinline__ void rope64(float* v, int t, const float2* T64) {
#pragma unroll
    for (int i = 0; i < 32; ++i) { const int pos = i < 16 ? (t >> 6) : (t & 63); const float2 cs = T64[pos * 16 + (i & 15)]; const float x1 = v[i], x2 = v[i + 32]; v[i] = x1 * cs.x - x2 * cs.y; v[i + 32] = x1 * cs.y + x2 * cs.x; }
}
__device__ __forceinline__ void rope32(float* v, int t, const float2* T32) {
#pragma unroll
    for (int i = 0; i < 16; ++i) { const int pos = i < 8 ? (t >> 6) : (t & 63); const float2 cs = T32[pos * 8 + (i & 7)]; const float x1 = v[i], x2 = v[i + 16]; v[i] = x1 * cs.x - x2 * cs.y; v[i + 16] = x1 * cs.y + x2 * cs.x; }
}
template <int NJ> __device__ __forceinline__ void dotrow(float* acc, const bf16* a, const float* w, int K, int ldw, const float* kscale) {
    for (int k = 0; k < K; ++k) { float av = bf2f(a[k]); if (kscale) av *= kscale[k]; const float* wr = w + (size_t)k * ldw;
#pragma unroll
        for (int j = 0; j < NJ; ++j) acc[j] += av * wr[j]; }
}
__device__ void ph_in(const Ctx& C, int gtid, int gsz) {
    const int l = C.layer; const float* W = C.p.w_in + (size_t)l * D * DIN;
    for (int task = gtid; task < 23 * MA; task += gsz) {
        const int slot = __builtin_amdgcn_readfirstlane(task / MA), r = task % MA; const RowInfo ri = row_info(r);
        float acc[64];
#pragma unroll
        for (int j = 0; j < 64; ++j) acc[j] = 0.f;
        const bf16* a = C.H + (size_t)r * D;
        if (slot < 22) dotrow<64>(acc, a, W + slot * 64, D, DIN, nullptr); else dotrow<32>(acc, a, W + 1408, D, DIN, nullptr);
        if (slot < 16) {
            const int grp = slot >> 2 & 1 ? 1 : 0;
            const bool isB = slot >= 8; const int s8 = slot & 7;
            const bool isq = s8 < 4, isk = s8 == 4 || s8 == 5; (void)grp;
            if (isB && (isq || isk)) { float ss = 0.f;
#pragma unroll
                for (int j = 0; j < 64; ++j) ss += acc[j] * acc[j];
                const float rs = rsqrtf(ss * (1.f / 64.f) + RMS_EPS); const float* g = (isq ? C.p.q_norm_b : C.p.k_norm_b) + l * 64;
#pragma unroll
                for (int j = 0; j < 64; ++j) acc[j] = acc[j] * rs * g[j]; }
            if ((isq || isk) && ri.lat) rope64(acc, ri.t, C.T64);
            if (isq) { bf16* q = (isB ? C.QB() : C.QA()) + (size_t)r * 256 + s8 * 64;
#pragma unroll
                for (int j = 0; j < 64; ++j) q[j] = f2bf(acc[j] * C2AB); }
            else if (isk) { bf16* k = isB ? C.KB(ri.b, s8 - 4) : C.KA(ri.b, s8 - 4);
#pragma unroll
                for (int j = 0; j < 64; ++j) k[kimg(ri.krow, j)] = f2bf(acc[j]); }
            else { bf16* v = isB ? C.VB(ri.b, s8 - 6) : C.VA(ri.b, s8 - 6);
#pragma unroll
                for (int j = 0; j < 64; ++j) v[vimg(ri.krow, j)] = f2bf(acc[j]); }
        } else if (slot < 22) {
            const int p = slot - 16; float ss = 0.f; bf16* o = C.AUP() + (size_t)r * 512 + p * 64;
#pragma unroll
            for (int j = 0; j < 64; ++j) { ss += acc[j] * acc[j]; o[j] = f2bf(acc[j]); }
            C.SSQ[(size_t)r * 8 + p] = ss;
            if (p >= 4) { C.SSQ[(size_t)r * 8 + p + 2] = 0.f;
#pragma unroll
                for (int j = 0; j < 64; ++j) o[128 + j] = 0; }
        } else {
            if (ri.lat) rope32(acc, ri.t, C.T32);
            bf16* k = C.KR(ri.b);
#pragma unroll
            for (int j = 0; j < 32; ++j) k[krimg(ri.krow, j)] = f2bf(acc[j]);
        }
    }
}
__device__ void ph_up(const Ctx& C, int gtid, int gsz) {
    const int l = C.layer;
    for (int task = gtid; task < 24 * MA; task += gsz) {
        const int g = __builtin_amdgcn_readfirstlane(task / MA), r = task % MA; const RowInfo ri = row_info(r);
        const float* sq = C.SSQ + (size_t)r * 8;
        float acc[96];
#pragma unroll
        for (int j = 0; j < 96; ++j) acc[j] = 0.f;
        if (g < 8) {
            const float rs = rsqrtf((sq[0] + sq[1] + sq[2] + sq[3]) * (1.f / 256.f) + RMS_EPS);
            dotrow<96>(acc, C.AUP() + (size_t)r * 512, C.p.w_uq + (size_t)l * 256 * 768 + g * 96, 256, 768, C.p.mla_q_norm + l * 256);
#pragma unroll
            for (int j = 0; j < 96; ++j) acc[j] *= rs;
            if (ri.lat) rope32(acc + 64, ri.t, C.T32);
            bf16* q = C.QC() + (size_t)r * 768 + g * 96;
#pragma unroll
            for (int j = 0; j < 96; ++j) q[j] = f2bf(acc[j] * C2C);
        } else {
            const float rs = rsqrtf((sq[4] + sq[5] + sq[6] + sq[7]) * (1.f / 128.f) + RMS_EPS); const int h = g & 7; const bool isk = g < 16;
            dotrow<64>(acc, C.AUP() + (size_t)r * 512 + 256, (isk ? C.p.w_uk : C.p.w_uv) + (size_t)l * 128 * 512 + h * 64, 128, 512, C.p.mla_kv_norm + l * 128);
            bf16* o = isk ? C.KC(ri.b, h) : C.VC(ri.b, h);
#pragma unroll
            for (int j = 0; j < 64; ++j) o[isk ? kimg(ri.krow, j) : vimg(ri.krow, j)] = f2bf(acc[j] * rs);
        }
    }
}
template <int DQK> __device__ void attn_unit(const Ctx& C, float* lds, int type  , int b, int h, int row0, int nq, bool lat) {
    float* Ks = lds; float* Vs = lds + 64 * DQK;
    const int tid = threadIdx.x; const bool act = tid < nq; const int r = row0 + (act ? tid : 0);
    const int kvh = type == 2 ? h : (h >> 1);
    const bf16* Kimg = type == 0 ? C.KA(b, kvh) : type == 1 ? C.KB(b, kvh) : C.KC(b, kvh);
    const bf16* Vimg = type == 0 ? C.VA(b, kvh) : type == 1 ? C.VB(b, kvh) : C.VC(b, kvh);
    const bf16* Q = type == 0 ? C.QA() + (size_t)r * 256 + h * 64 : type == 1 ? C.QB() + (size_t)r * 256 + h * 64 : C.QC() + (size_t)r * 768 + h * 96;
    float q[DQK], o[64];
#pragma unroll
    for (int j = 0; j < DQK; ++j) q[j] = bf2f(Q[j]);
#pragma unroll
    for (int j = 0; j < 64; ++j) o[j] = 0.f;
    float m = -1e30f, lsum = 0.f;
    const int qpos = lat ? (r & (SEQ - 1)) : 0;
    int tlo = 4, thi = lat ? NTILE : 4;
    if (type == 0 && lat) { const int p0 = (row0 & (SEQ - 1)); int lo = p0 - 128, hi = p0 + nq + 128; if (lo < 0) lo = 0; if (hi > SEQ) hi = SEQ; tlo = 4 + lo / 64; thi = 4 + hi / 64; }
    for (int pass = 0; pass < 2; ++pass) {
        const int ta = pass == 0 ? 0 : tlo, tb = pass == 0 ? 4 : thi;
        for (int t = ta; t < tb; ++t) {
            __syncthreads();
            for (int e = tid; e < 64 * DQK; e += NTHREADS) { const int key = e / DQK, d = e % DQK;
                Ks[e] = d < 64 ? bf2f(Kimg[kimg(t * 64 + key, d)]) : bf2f(C.KR(b)[krimg(t * 64 + key, d - 64)]); }
            for (int e = tid; e < 64 * 64; e += NTHREADS) { const int key = e >> 6, d = e & 63; Vs[e] = bf2f(Vimg[vimg(t * 64 + key, d)]); }
            __syncthreads();
            for (int key = 0; key < 64; ++key) {
                float s = 0.f;
#pragma unroll
                for (int j = 0; j < DQK; ++j) s += q[j] * Ks[key * DQK + j];
                if (type == 0 && t >= 4) { const int kpos = (t - 4) * 64 + key; const int rel = kpos - qpos; if (rel > 128 || rel < -128) s = -1e30f; }
                if (s > m) { const float f = exp2f(m - s); lsum *= f;
#pragma unroll
                    for (int j = 0; j < 64; ++j) o[j] *= f;
                    m = s; }
                const float pr = exp2f(s - m); lsum += pr;
#pragma unroll
                for (int j = 0; j < 64; ++j) o[j] += pr * Vs[key * 64 + j];
            }
        }
    }
    if (type == 0) lsum += exp2f(C.p.sink_a[C.layer * 4 + h] * LOG2E - m);
    if (act) { const float inv = 1.f / lsum; bf16* y = C.Y() + (size_t)r * D + (type == 0 ? 0 : type == 1 ? 256 : 512) + h * 64;
#pragma unroll
        for (int j = 0; j < 64; ++j) y[j] = f2bf(o[j] * inv); }
}
__device__ void ph_attn(const Ctx& C, float* lds, bool with_ctx) {
    const int nlat = 128 + 128 + 256, nctx = with_ctx ? 32 : 0;
    for (int u = blockIdx.x; u < nlat + nctx; u += gridDim.x) {
        if (u < nlat) {
            int type, idx; if (u < 128) { type = 0; idx = u; } else if (u < 256) { type = 1; idx = u - 128; } else { type = 2; idx = u - 256; }
            const int nh = type == 2 ? 8 : 4; const int qb = idx & 15, h = (idx >> 4) % nh, b = (idx >> 4) / nh;
            if (type == 2) attn_unit<96>(C, lds, type, b, h, b * SEQ + qb * 512, 512, true); else attn_unit<64>(C, lds, type, b, h, b * SEQ + qb * 512, 512, true);
        } else {
            const int v = u - nlat; int type, idx; if (v < 8) { type = 0; idx = v; } else if (v < 16) { type = 1; idx = v - 8; } else { type = 2; idx = v - 16; }
            const int nh = type == 2 ? 8 : 4; const int h = idx % nh, b = idx / nh;
            if (type == 2) attn_unit<96>(C, lds, type, b, h, ML + b * CTX, 256, false); else attn_unit<64>(C, lds, type, b, h, ML + b * CTX, 256, false);
        }
    }
}
__device__ void ph_proj_res(const Ctx& C, int gtid, int gsz, const bf16* A, int K, const float* W  , int which_gate, int nrows, bool first) {
    for (int task = gtid; task < 16 * nrows; task += gsz) {
        const int cgp = __builtin_amdgcn_readfirstlane(task / nrows), r = task % nrows; const RowInfo ri = row_info(r);
        float acc[64];
#pragma unroll
        for (int j = 0; j < 64; ++j) acc[j] = 0.f;
        dotrow<64>(acc, A + (size_t)r * K, W + cgp * 64, K, D, nullptr);
        const float* base = first ? C.resid_in(r) : C.resid(r); float* o = C.resid(r); const float* g = C.mod(ri.set, which_gate);
#pragma unroll
        for (int j = 0; j < 64; ++j) { const int c = cgp * 64 + j; o[c] = ALPHA * base[c] + g[c] * acc[j]; }
    }
}
__device__ void ph_fc1(const Ctx& C, int gtid, int gsz, int nrows) {
    const float* W = C.p.w_fc1 + (size_t)C.layer * D * DFF;
    for (int task = gtid; task < 64 * nrows; task += gsz) {
        const int cgp = __builtin_amdgcn_readfirstlane(task / nrows), r = task % nrows;
        float acc[64];
#pragma unroll
        for (int j = 0; j < 64; ++j) acc[j] = 0.f;
        dotrow<64>(acc, C.H + (size_t)r * D, W + cgp * 64, D, DFF, nullptr);
        bf16* o = C.HID() + (size_t)r * DFF + cgp * 64;
#pragma unroll
        for (int j = 0; j < 64; ++j) { const float a = fmaxf(acc[j], 0.f); o[j] = f2bf(a * a); }
    }
}
}

__device__ void ph_ln(const Ctx& C, int nrows, const float* g, const float* bta, bool make_h, int mlayer, int which_sh, float* final_out_unused) {
    const int lane = threadIdx.x & 63, gw = blockIdx.x * (NTHREADS / 64) + (threadIdx.x >> 6), ngw = gridDim.x * (NTHREADS / 64);
    for (int r = gw; r < nrows; r += ngw) {
        float* xr = C.resid(r); const RowInfo ri = row_info(r);
        float4 v[4]; float s = 0.f;
#pragma unroll
        for (int j = 0; j < 4; ++j) { v[j] = *(const float4*)(xr + 4 * lane + 256 * j); s += (v[j].x + v[j].y) + (v[j].z + v[j].w); }
        const float mean = wave_sum(s) * (1.f / D); float s2 = 0.f;
#pragma unroll
        for (int j = 0; j < 4; ++j) { v[j].x -= mean; v[j].y -= mean; v[j].z -= mean; v[j].w -= mean; s2 += (v[j].x * v[j].x + v[j].y * v[j].y) + (v[j].z * v[j].z + v[j].w * v[j].w); }
        const float rstd = rsqrtf(wave_sum(s2) * (1.f / D) + LN_EPS);
        const float* sc = C.MOD + ((size_t)(mlayer * 3 + ri.set) * 6 + which_sh + 1) * D; const float* sh = C.MOD + ((size_t)(mlayer * 3 + ri.set) * 6 + which_sh) * D;
#pragma unroll
        for (int j = 0; j < 4; ++j) { const int c = 4 * lane + 256 * j; const float4 gg = *(const float4*)(g + c), bb = *(const float4*)(bta + c);
            float4 y; y.x = v[j].x * rstd * gg.x + bb.x; y.y = v[j].y * rstd * gg.y + bb.y; y.z = v[j].z * rstd * gg.z + bb.z; y.w = v[j].w * rstd * gg.w + bb.w;
            *(float4*)(xr + c) = y;
            if (make_h) { const float4 a = *(const float4*)(sc + c), d = *(const float4*)(sh + c); ushort4 o;
                o.x = f2bf(y.x * (1.f + a.x) + d.x); o.y = f2bf(y.y * (1.f + a.y) + d.y); o.z = f2bf(y.z * (1.f + a.z) + d.z); o.w = f2bf(y.w * (1.f + a.w) + d.w);
                *(ushort4*)(C.H + (size_t)r * D + c) = o; } }
    }
}

__global__ void __launch_bounds__(NTHREADS, 2) fwd_kernel(Params p) {
    extern __shared__ __attribute__((aligned(16))) unsigned char lds[];
    cg::grid_group grid = cg::this_grid();
    Ctx C; C.p = p; C.layer = 0;
    C.MOD = (float*)(p.ws + WS_MOD); C.T64 = (float2*)(p.ws + WS_T64); C.T32 = (float2*)(p.ws + WS_T32); C.SSQ = (float*)(p.ws + WS_SSQ);
    C.RC = (float*)(p.ws + WS_RC); C.H = (bf16*)(p.ws + WS_H); C.R = p.ws + WS_R;
    const int gtid = blockIdx.x * NTHREADS + threadIdx.x, gsz = gridDim.x * NTHREADS;

    nv::ph_mod_tables(C, gtid, gsz);
    grid.sync();
    nv::ph_modulate(C, gtid, gsz, MA);
    grid.sync();
    for (int l = 0; l < DEPTH; ++l) {
        C.layer = l; const bool last = l == DEPTH - 1; const int nrows = last ? ML : MA;
        nv::ph_in(C, gtid, gsz);
        grid.sync();
        nv::ph_up(C, gtid, gsz);
        grid.sync();
        nv::ph_attn(C, (float*)lds, !last);
        grid.sync();
        nv::ph_proj_res(C, gtid, gsz, C.Y(), D, p.w_out + (size_t)l * D * D, 2, nrows, true);
        grid.sync();
        ph_ln(C, nrows, p.ln1_g + l * D, p.ln1_b + l * D, true, l, 3, nullptr);
        grid.sync();
        nv::ph_fc1(C, gtid, gsz, nrows);
        grid.sync();
        nv::ph_proj_res(C, gtid, gsz, C.HID(), DFF, p.w_fc2 + (size_t)l * DFF * D, 5, nrows, false);
        grid.sync();
        ph_ln(C, nrows, p.ln2_g + l * D, p.ln2_b + l * D, !last, l + 1, 0, nullptr);
        grid.sync();
    }
}

constexpr int LDS_BYTES = 64 * 1024;
extern "C" void kernel_launch(void* const* d_in, const int* in_sizes, int n_in, void* d_out, int out_size, void* d_ws, size_t ws_size, hipStream_t stream) {
    static int grid = 0;
    if (grid == 0) {
        if (n_in != 22 || out_size != ML * D || ws_size < WS_END) { fprintf(stderr, "kernel_launch: unexpected shapes n_in %d out %d ws %zu (need %zu)\n", n_in, out_size, ws_size, (size_t)WS_END); grid = -1; return; }
        int dev = 0, cus = 0, per_cu = 0;
        hipGetDevice(&dev); hipDeviceGetAttribute(&cus, hipDeviceAttributeMultiprocessorCount, dev);
        hipFuncSetAttribute((const void*)fwd_kernel, hipFuncAttributeMaxDynamicSharedMemorySize, LDS_BYTES);
        hipOccupancyMaxActiveBlocksPerMultiprocessor(&per_cu, (const void*)fwd_kernel, NTHREADS, LDS_BYTES);
        if (per_cu < 1) { fprintf(stderr, "kernel_launch: occupancy query says %d blocks per CU\n", per_cu); grid = -1; return; }
        grid = cus;
    }
    if (grid < 0) return;
    hipMemsetAsync((char*)d_ws + WS_CTL, 0, 1 * MiB, stream);
    Params p{};
    const float** pp = (const float**)&p;
    for (int i = 0; i < 22; ++i) pp[i] = (const float*)d_in[i];
    p.out = (float*)d_out; p.ws = (unsigned char*)d_ws;
    void* args[] = {&p};
    hipError_t e = hipLaunchCooperativeKernel((const void*)fwd_kernel, dim3(grid), dim3(NTHREADS), args, LDS_BYTES, stream);
    if (e != hipSuccess) fprintf(stderr, "cooperative launch failed: %s (grid %d)\n", hipGetErrorString(e), grid);
}
```

```cpp
#include <hip/hip_runtime.h>
#include <hip/hip_cooperative_groups.h>
#include <cstdio>
#include <cstdint>
namespace cg = cooperative_groups;

constexpr int D = 1024, NB = 2, SEQ = 8192, CTX = 256, DEPTH = 2;
constexpr int ML = NB * SEQ, MC = NB * CTX, MA = ML + MC;
constexpr int DIN = 1440, DFF = 4096, DMOD = 6 * D;
constexpr int KROWS = CTX + SEQ, NTILE = KROWS / 64;
constexpr float LN_EPS = 1e-6f, RMS_EPS = 1e-6f;
constexpr float ALPHA = 1.41421356237309515f;
constexpr float LOG2E = 1.4426950408889634f;
constexpr float C2AB = 0.125f * LOG2E;
constexpr float C2C = 0.10206207261596577f * LOG2E;
constexpr int NTHREADS = 512;

typedef unsigned short bf16;

constexpr size_t MiB = 1u << 20;
constexpr size_t al(size_t x) { return (x + 255) & ~(size_t)255; }
constexpr size_t WS_CTL = 0;
constexpr size_t WS_MOD = 1 * MiB;
constexpr size_t WS_T64 = WS_MOD + al((size_t)DEPTH * 3 * DMOD * 4);
constexpr size_t WS_T32 = WS_T64 + al(128 * 16 * 8);
constexpr size_t WS_SSQ = WS_T32 + al(128 * 8 * 8);
constexpr size_t WS_RC = WS_SSQ + al((size_t)MA * 8 * 4);
constexpr size_t WS_H = WS_RC + al((size_t)MC * D * 4);
constexpr size_t WS_W = WS_H + al((size_t)MA * D * 2);
constexpr size_t W_IN = 0, W_UP = W_IN + (size_t)1536 * 1024 * 2, W_OUT = W_UP + (size_t)1792 * 256 * 2,
                 W_FC1 = W_OUT + (size_t)1024 * 1024 * 2, W_FC2 = W_FC1 + (size_t)4096 * 1024 * 2, W_LAYER = W_FC2 + (size_t)4096 * 1024 * 2;
constexpr size_t WS_R = WS_W + al(DEPTH * W_LAYER);
constexpr size_t R_QA = 0, R_QB = R_QA + (size_t)MA * 256 * 2, R_QC = R_QB + (size_t)MA * 256 * 2, R_AUP = R_QC + (size_t)MA * 768 * 2,
                 R_KA = R_AUP + (size_t)MA * 512 * 2, IMG64 = (size_t)NTILE * 4096 * 2  ,
                 R_VA = R_KA + 4 * IMG64, R_KB = R_VA + 4 * IMG64, R_VB = R_KB + 4 * IMG64, R_KC = R_VB + 4 * IMG64, R_VC = R_KC + 16 * IMG64,
                 R_KR = R_VC + 16 * IMG64, R_Y = R_KR + 2 * IMG64 / 2, R_END = R_Y + (size_t)MA * D * 2;
constexpr size_t R_HID = 0;
static_assert((size_t)MA * DFF * 2 <= R_END, "hid overlay");
constexpr size_t WS_END = WS_R + R_END;
static_assert(WS_END <= 256 * MiB, "workspace");

struct Params {
    const float *x, *c, *ctx, *c_ctx, *w_mod, *b_mod, *w_in, *sink_a, *q_norm_b, *k_norm_b, *mla_q_norm, *mla_kv_norm,
        *w_uq, *w_uk, *w_uv, *w_out, *ln1_g, *ln1_b, *w_fc1, *w_fc2, *ln2_g, *ln2_b;
    float* out; unsigned char* ws;
};

__device__ __forceinline__ unsigned f2bf(float f) { unsigned u = __builtin_bit_cast(unsigned, f); return (u + 0x7fffu + ((u >> 16) & 1u)) >> 16; }
__device__ __forceinline__ int otid(int wave) {
    int l; asm volatile("v_mbcnt_lo_u32_b32 %0, -1, 0\n\tv_mbcnt_hi_u32_b32 %0, -1, %0" : "=v"(l)); return wave * 64 + l; }
__device__ __forceinline__ int obid() { int b = blockIdx.x; asm volatile("" : "+s"(b)); return b; }
__device__ __forceinline__ int ogrid() { int g = gridDim.x; asm volatile("" : "+s"(g)); return g; }
__device__ __forceinline__ float bf2f(unsigned h) { return __builtin_bit_cast(float, h << 16); }
__device__ __forceinline__ float wave_sum(float v) {
#pragma unroll
    for (int o = 1; o < 64; o <<= 1) v += __shfl_xor(v, o);
    return v;
}
__device__ __forceinline__ size_t kimg(int krow, int d) { return ((size_t)((krow >> 6) * 8 + (d >> 3)) * 64 + (krow & 63)) * 8 + (d & 7); }
__device__ __forceinline__ size_t krimg(int krow, int d) { return ((size_t)((krow >> 6) * 4 + (d >> 3)) * 64 + (krow & 63)) * 8 + (d & 7); }
__device__ __forceinline__ size_t vimg(int krow, int d) { const int rr = krow & 63; return (size_t)(krow >> 6) * 4096 + (d >> 5) * 2048 + (rr >> 4) * 512 + (rr & 15) * 32 + (d & 31); }
struct RowInfo { int b, krow, set, t; bool lat; };
__device__ __forceinline__ RowInfo row_info(int r) {
    RowInfo ri;
    if (r < ML) { ri.b = r >> 13; ri.t = r & (SEQ - 1); ri.krow = CTX + ri.t; ri.set = ri.b; ri.lat = true; }
    else { const int j = r - ML; ri.b = j >> 8; ri.t = 0; ri.krow = j & 255; ri.set = 2; ri.lat = false; }
    return ri;
}
struct Ctx {
    Params p; int layer, wave;
    __device__ __forceinline__ int tid() const { return otid(wave); }
    float* MOD; float2* T64; float2* T32; float* SSQ; float* RC; bf16* H; unsigned char* R;
    __device__ __forceinline__ const float* mod(int set, int which) const { return MOD + ((size_t)(layer * 3 + set) * 6 + which) * D; }
    __device__ __forceinline__ const float* resid_in(int r) const {
        if (layer == 0) return r < ML ? p.x + (size_t)r * D : p.ctx + (size_t)(r - ML) * D;
        return r < ML ? p.out + (size_t)r * D : RC + (size_t)(r - ML) * D; }
    __device__ __forceinline__ float* resid(int r) const { return r < ML ? p.out + (size_t)r * D : RC + (size_t)(r - ML) * D; }
    __device__ __forceinline__ bf16* QA() const { return (bf16*)(R + R_QA); }
    __device__ __forceinline__ bf16* QB() const { return (bf16*)(R + R_QB); }
    __device__ __forceinline__ bf16* QC() const { return (bf16*)(R + R_QC); }
    __device__ __forceinline__ bf16* AUP() const { return (bf16*)(R + R_AUP); }
    __device__ __forceinline__ bf16* KA(int b, int kv) const { return (bf16*)(R + R_KA + (size_t)(b * 2 + kv) * IMG64); }
    __device__ __forceinline__ bf16* VA(int b, int kv) const { return (bf16*)(R + R_VA + (size_t)(b * 2 + kv) * IMG64); }
    __device__ __forceinline__ bf16* KB(int b, int kv) const { return (bf16*)(R + R_KB + (size_t)(b * 2 + kv) * IMG64); }
    __device__ __forceinline__ bf16* VB(int b, int kv) const { return (bf16*)(R + R_VB + (size_t)(b * 2 + kv) * IMG64); }
    __device__ __forceinline__ bf16* KC(int b, int h) const { return (bf16*)(R + R_KC + (size_t)(b * 8 + h) * IMG64); }
    __device__ __forceinline__ bf16* VC(int b, int h) const { return (bf16*)(R + R_VC + (size_t)(b * 8 + h) * IMG64); }
    __device__ __forceinline__ bf16* KR(int b) const { return (bf16*)(R + R_KR + (size_t)b * (IMG64 / 2)); }
    __device__ __forceinline__ bf16* Y() const { return (bf16*)(R + R_Y); }
    __device__ __forceinline__ bf16* HID() const { return (bf16*)(R + R_HID); }
};

namespace nv {
__device__ __forceinline__ float silu(float v) { return v / (1.f + expf(-v)); }

__device__ __forceinline__ void ph_mod_tables(const Ctx& C, int gtid, int gsz) {
    for (int idx = gtid; idx < DEPTH * 3 * DMOD; idx += gsz) {
        const int l = idx / (3 * DMOD), s = (idx / DMOD) % 3, n = idx % DMOD;
        const float* cv = s < 2 ? C.p.c + s * D : C.p.c_ctx;
        const float* w = C.p.w_mod + (size_t)l * D * DMOD + n;
        float acc = C.p.b_mod[l * DMOD + n];
        for (int k = 0; k < D; ++k) acc += silu(cv[k]) * w[(size_t)k * DMOD];
        C.MOD[idx] = acc;
    }
    for (int idx = gtid; idx < 128 * 16; idx += gsz) { const int pos = idx >> 4, j = idx & 15; const float inv = powf(10000.f, -(float)j / 16.f), a = (float)pos * inv; C.T64[idx] = make_float2(cosf(a), sinf(a)); }
    for (int idx = gtid; idx < 128 * 8; idx += gsz) { const int pos = idx >> 3, j = idx & 7; const float inv = powf(10000.f, -(float)j / 8.f), a = (float)pos * inv; C.T32[idx] = make_float2(cosf(a), sinf(a)); }
}
__device__ __forceinline__ void ph_modulate(const Ctx& C, int gtid, int gsz, int nrows) {
    for (size_t idx = gtid; idx < (size_t)nrows * (D / 4); idx += gsz) {
        const int r = (int)(idx / (D / 4)), c4 = (int)(idx % (D / 4)) * 4; const RowInfo ri = row_info(r);
        const float4 v = *(const float4*)(C.resid_in(r) + c4); const float4 sc = *(const float4*)(C.mod(ri.set, 1) + c4), sh = *(const float4*)(C.mod(ri.set, 0) + c4);
        ushort4 o; o.x = f2bf(v.x * (1.f + sc.x) + sh.x); o.y = f2bf(v.y * (1.f + sc.y) + sh.y); o.z = f2bf(v.z * (1.f + sc.z) + sh.z); o.w = f2bf(v.w * (1.f + sc.w) + sh.w);
        *(ushort4*)(C.H + (size_t)r * D + c4) = o;
    }
}
__device__ __forceinline__ void rope64(float* v, int t, const float2* T64) {
#pragma unroll
    for (int i = 0; i < 32; ++i) { const int pos = i < 16 ? (t >> 6) : (t & 63); const float2 cs = T64[pos * 16 + (i & 15)]; const float x1 = v[i], x2 = v[i + 32]; v[i] = x1 * cs.x - x2 * cs.y; v[i + 32] = x1 * cs.y + x2 * cs.x; }
}
__device__ __forceinline__ void rope32(float* v, int t, const float2* T32) {
#pragma unroll
    for (int i = 0; i < 16; ++i) { const int pos = i < 8 ? (t >> 6) : (t & 63); const float2 cs = T32[pos * 8 + (i & 7)]; const float x1 = v[i], x2 = v[i + 16]; v[i] = x1 * cs.x - x2 * cs.y; v[i + 16] = x1 * cs.y + x2 * cs.x; }
}
template <int NJ> __device__ __forceinline__ void dotrow(float* acc, const bf16* a, const float* w, int K, int ldw, const float* kscale) {
    for (int k = 0; k < K; ++k) { float av = bf2f(a[k]); if (kscale) av *= kscale[k]; const float* wr = w + (size_t)k * ldw;
#pragma unroll
        for (int j = 0; j < NJ; ++j) acc[j] += av * wr[j]; }
}
__device__ __forceinline__ void ph_in(const Ctx& C, int gtid, int gsz) {
    const int l = C.layer; const float* W = C.p.w_in + (size_t)l * D * DIN;
    for (int task = gtid; task < 23 * MA; task += gsz) {
        const int slot = __builtin_amdgcn_readfirstlane(task / MA), r = task % MA; const RowInfo ri = row_info(r);
        float acc[64];
#pragma unroll
        for (int j = 0; j < 64; ++j) acc[j] = 0.f;
        const bf16* a = C.H + (size_t)r * D;
        if (slot < 22) dotrow<64>(acc, a, W + slot * 64, D, DIN, nullptr); else dotrow<32>(acc, a, W + 1408, D, DIN, nullptr);
        if (slot < 16) {
            const int grp = slot >> 2 & 1 ? 1 : 0;
            const bool isB = slot >= 8; const int s8 = slot & 7;
            const bool isq = s8 < 4, isk = s8 == 4 || s8 == 5; (void)grp;
            if (isB && (isq || isk)) { float ss = 0.f;
#pragma unroll
                for (int j = 0; j < 64; ++j) ss += acc[j] * acc[j];
                const float rs = rsqrtf(ss * (1.f / 64.f) + RMS_EPS); const float* g = (isq ? C.p.q_norm_b : C.p.k_norm_b) + l * 64;
#pragma unroll
                for (int j = 0; j < 64; ++j) acc[j] = acc[j] * rs * g[j]; }
            if ((isq || isk) && ri.lat) rope64(acc, ri.t, C.T64);
            if (isq) { bf16* q = (isB ? C.QB() : C.QA()) + (size_t)r * 256 + s8 * 64;
#pragma unroll
                for (int j = 0; j < 64; ++j) q[j] = f2bf(acc[j] * C2AB); }
            else if (isk) { bf16* k = isB ? C.KB(ri.b, s8 - 4) : C.KA(ri.b, s8 - 4);
#pragma unroll
                for (int j = 0; j < 64; ++j) k[kimg(ri.krow, j)] = f2bf(acc[j]); }
            else { bf16* v = isB ? C.VB(ri.b, s8 - 6) : C.VA(ri.b, s8 - 6);
#pragma unroll
                for (int j = 0; j < 64; ++j) v[vimg(ri.krow, j)] = f2bf(acc[j]); }
        } else if (slot < 22) {
            const int p = slot - 16; float ss = 0.f; bf16* o = C.AUP() + (size_t)r * 512 + p * 64;
#pragma unroll
            for (int j = 0; j < 64; ++j) { ss += acc[j] * acc[j]; o[j] = f2bf(acc[j]); }
            C.SSQ[(size_t)r * 8 + p] = ss;
            if (p >= 4) { C.SSQ[(size_t)r * 8 + p + 2] = 0.f;
#pragma unroll
                for (int j = 0; j < 64; ++j) o[128 + j] = 0; }
        } else {
            if (ri.lat) rope32(acc, ri.t, C.T32);
            bf16* k = C.KR(ri.b);
#pragma unroll
            for (int j = 0; j < 32; ++j) k[krimg(ri.krow, j)] = f2bf(acc[j]);
        }
    }
}
__device__ __forceinline__ void ph_up(const Ctx& C, int gtid, int gsz) {
    const int l = C.layer;
    for (int task = gtid; task < 24 * MA; task += gsz) {
        const int g = __builtin_amdgcn_readfirstlane(task / MA), r = task % MA; const RowInfo ri = row_info(r);
        const float* sq = C.SSQ + (size_t)r * 8;
        float acc[96];
#pragma unroll
        for (int j = 0; j < 96; ++j) acc[j] = 0.f;
        if (g < 8) {
            const float rs = rsqrtf((sq[0] + sq[1] + sq[2] + sq[3]) * (1.f / 256.f) + RMS_EPS);
            dotrow<96>(acc, C.AUP() + (size_t)r * 512, C.p.w_uq + (size_t)l * 256 * 768 + g * 96, 256, 768, C.p.mla_q_norm + l * 256);
#pragma unroll
            for (int j = 0; j < 96; ++j) acc[j] *= rs;
            if (ri.lat) rope32(acc + 64, ri.t, C.T32);
            bf16* q = C.QC() + (size_t)r * 768 + g * 96;
#pragma unroll
            for (int j = 0; j < 96; ++j) q[j] = f2bf(acc[j] * C2C);
        } else {
            const float rs = rsqrtf((sq[4] + sq[5] + sq[6] + sq[7]) * (1.f / 128.f) + RMS_EPS); const int h = g & 7; const bool isk = g < 16;
            dotrow<64>(acc, C.AUP() + (size_t)r * 512 + 256, (isk ? C.p.w_uk : C.p.w_uv) + (size_t)l * 128 * 512 + h * 64, 128, 512, C.p.mla_kv_norm + l * 128);
            bf16* o = isk ? C.KC(ri.b, h) : C.VC(ri.b, h);
#pragma unroll
            for (int j = 0; j < 64; ++j) o[isk ? kimg(ri.krow, j) : vimg(ri.krow, j)] = f2bf(acc[j] * rs);
        }
    }
}
template <int DQK> __device__ __forceinline__ void attn_unit(const Ctx& C, float* lds, int type  , int b, int h, int row0, int nq, bool lat) {
    float* Ks = lds; float* Vs = lds + 64 * DQK;
    const int tid = C.tid(); const bool act = tid < nq; const int r = row0 + (act ? tid : 0);
    const int kvh = type == 2 ? h : (h >> 1);
    const bf16* Kimg = type == 0 ? C.KA(b, kvh) : type == 1 ? C.KB(b, kvh) : C.KC(b, kvh);
    const bf16* Vimg = type == 0 ? C.VA(b, kvh) : type == 1 ? C.VB(b, kvh) : C.VC(b, kvh);
    const bf16* Q = type == 0 ? C.QA() + (size_t)r * 256 + h * 64 : type == 1 ? C.QB() + (size_t)r * 256 + h * 64 : C.QC() + (size_t)r * 768 + h * 96;
    float q[DQK], o[64];
#pragma unroll
    for (int j = 0; j < DQK; ++j) q[j] = bf2f(Q[j]);
#pragma unroll
    for (int j = 0; j < 64; ++j) o[j] = 0.f;
    float m = -1e30f, lsum = 0.f;
    const int qpos = lat ? (r & (SEQ - 1)) : 0;
    int tlo = 4, thi = lat ? NTILE : 4;
    if (type == 0 && lat) { const int p0 = (row0 & (SEQ - 1)); int lo = p0 - 128, hi = p0 + nq + 128; if (lo < 0) lo = 0; if (hi > SEQ) hi = SEQ; tlo = 4 + lo / 64; thi = 4 + hi / 64; }
    for (int pass = 0; pass < 2; ++pass) {
        const int ta = pass == 0 ? 0 : tlo, tb = pass == 0 ? 4 : thi;
        for (int t = ta; t < tb; ++t) {
            __syncthreads();
            for (int e = tid; e < 64 * DQK; e += NTHREADS) { const int key = e / DQK, d = e % DQK;
                Ks[e] = d < 64 ? bf2f(Kimg[kimg(t * 64 + key, d)]) : bf2f(C.KR(b)[krimg(t * 64 + key, d - 64)]); }
            for (int e = tid; e < 64 * 64; e += NTHREADS) { const int key = e >> 6, d = e & 63; Vs[e] = bf2f(Vimg[vimg(t * 64 + key, d)]); }
            __syncthreads();
            for (int key = 0; key < 64; ++key) {
                float s = 0.f;
#pragma unroll
                for (int j = 0; j < DQK; ++j) s += q[j] * Ks[key * DQK + j];
                if (type == 0 && t >= 4) { const int kpos = (t - 4) * 64 + key; const int rel = kpos - qpos; if (rel > 128 || rel < -128) s = -1e30f; }
                if (s > m) { const float f = exp2f(m - s); lsum *= f;
#pragma unroll
                    for (int j = 0; j < 64; ++j) o[j] *= f;
                    m = s; }
                const float pr = exp2f(s - m); lsum += pr;
#pragma unroll
                for (int j = 0; j < 64; ++j) o[j] += pr * Vs[key * 64 + j];
            }
        }
    }
    if (type == 0) lsum += exp2f(C.p.sink_a[C.layer * 4 + h] * LOG2E - m);
    if (act) { const float inv = 1.f / lsum; bf16* y = C.Y() + (size_t)r * D + (type == 0 ? 0 : type == 1 ? 256 : 512) + h * 64;
#pragma unroll
        for (int j = 0; j < 64; ++j) y[j] = f2bf(o[j] * inv); }
}
__device__ __forceinline__ void ph_attn(const Ctx& C, float* lds, bool with_ctx) {
    const int nlat = 128 + 128 + 256, nctx = with_ctx ? 32 : 0;
    for (int u = obid(); u < nlat + nctx; u += ogrid()) {
        if (u < nlat) {
            int type, idx; if (u < 128) { type = 0; idx = u; } else if (u < 256) { type = 1; idx = u - 128; } else { type = 2; idx = u - 256; }
            const int nh = type == 2 ? 8 : 4; const int qb = idx & 15, h = (idx >> 4) % nh, b = (idx >> 4) / nh;
            if (type == 2) attn_unit<96>(C, lds, type, b, h, b * SEQ + qb * 512, 512, true); else attn_unit<64>(C, lds, type, b, h, b * SEQ + qb * 512, 512, true);
        } else {
            const int v = u - nlat; int type, idx; if (v < 8) { type = 0; idx = v; } else if (v < 16) { type = 1; idx = v - 8; } else { type = 2; idx = v - 16; }
            const int nh = type == 2 ? 8 : 4; const int h = idx % nh, b = idx / nh;
            if (type == 2) attn_unit<96>(C, lds, type, b, h, ML + b * CTX, 256, false); else attn_unit<64>(C, lds, type, b, h, ML + b * CTX, 256, false);
        }
    }
}
__device__ __forceinline__ void ph_proj_res(const Ctx& C, int gtid, int gsz, const bf16* A, int K, const float* W  , int which_gate, int nrows, bool first) {
    for (int task = gtid; task < 16 * nrows; task += gsz) {
        const int cgp = __builtin_amdgcn_readfirstlane(task / nrows), r = task % nrows; const RowInfo ri = row_info(r);
        float acc[64];
#pragma unroll
        for (int j = 0; j < 64; ++j) acc[j] = 0.f;
        dotrow<64>(acc, A + (size_t)r * K, W + cgp * 64, K, D, nullptr);
        const float* base = first ? C.resid_in(r) : C.resid(r); float* o = C.resid(r); const float* g = C.mod(ri.set, which_gate);
#pragma unroll
        for (int j = 0; j < 64; ++j) { const int c = cgp * 64 + j; o[c] = ALPHA * base[c] + g[c] * acc[j]; }
    }
}
__device__ __forceinline__ void ph_fc1(const Ctx& C, int gtid, int gsz, int nrows) {
    const float* W = C.p.w_fc1 + (size_t)C.layer * D * DFF;
    for (int task = gtid; task < 64 * nrows; task += gsz) {
        const int cgp = __builtin_amdgcn_readfirstlane(task / nrows), r = task % nrows;
        float acc[64];
#pragma unroll
        for (int j = 0; j < 64; ++j) acc[j] = 0.f;
        dotrow<64>(acc, C.H + (size_t)r * D, W + cgp * 64, D, DFF, nullptr);
        bf16* o = C.HID() + (size_t)r * DFF + cgp * 64;
#pragma unroll
        for (int j = 0; j < 64; ++j) { const float a = fmaxf(acc[j], 0.f); o[j] = f2bf(a * a); }
    }
}
}

__device__ __forceinline__ void ph_ln(const Ctx& C, int nrows, const float* g, const float* bta, bool make_h, int mlayer, int which_sh, float* final_out_unused) {
    const int tid_ = C.tid(); const int lane = tid_ & 63, gw = obid() * (NTHREADS / 64) + (tid_ >> 6), ngw = ogrid() * (NTHREADS / 64);
    for (int r = gw; r < nrows; r += ngw) {
        float* xr = C.resid(r); const RowInfo ri = row_info(r);
        float4 v[4]; float s = 0.f;
#pragma unroll
        for (int j = 0; j < 4; ++j) { v[j] = *(const float4*)(xr + 4 * lane + 256 * j); s += (v[j].x + v[j].y) + (v[j].z + v[j].w); }
        const float mean = wave_sum(s) * (1.f / D); float s2 = 0.f;
#pragma unroll
        for (int j = 0; j < 4; ++j) { v[j].x -= mean; v[j].y -= mean; v[j].z -= mean; v[j].w -= mean; s2 += (v[j].x * v[j].x + v[j].y * v[j].y) + (v[j].z * v[j].z + v[j].w * v[j].w); }
        const float rstd = rsqrtf(wave_sum(s2) * (1.f / D) + LN_EPS);
        const float* sc = C.MOD + ((size_t)(mlayer * 3 + ri.set) * 6 + which_sh + 1) * D; const float* sh = C.MOD + ((size_t)(mlayer * 3 + ri.set) * 6 + which_sh) * D;
#pragma unroll
        for (int j = 0; j < 4; ++j) { const int c = 4 * lane + 256 * j; const float4 gg = *(const float4*)(g + c), bb = *(const float4*)(bta + c);
            float4 y; y.x = v[j].x * rstd * gg.x + bb.x; y.y = v[j].y * rstd * gg.y + bb.y; y.z = v[j].z * rstd * gg.z + bb.z; y.w = v[j].w * rstd * gg.w + bb.w;
            *(float4*)(xr + c) = y;
            if (make_h) { const float4 a = *(const float4*)(sc + c), d = *(const float4*)(sh + c); ushort4 o;
                o.x = f2bf(y.x * (1.f + a.x) + d.x); o.y = f2bf(y.y * (1.f + a.y) + d.y); o.z = f2bf(y.z * (1.f + a.z) + d.z); o.w = f2bf(y.w * (1.f + a.w) + d.w);
                *(ushort4*)(C.H + (size_t)r * D + c) = o; } }
    }
}


namespace pg8 {
#define PG8_LAS __attribute__((address_space(3)))
typedef PG8_LAS unsigned char* PG8_LAS_T;
typedef unsigned short bf16_t;
typedef short bf16x8 __attribute__((ext_vector_type(8)));
typedef float f32x4 __attribute__((ext_vector_type(4)));
typedef unsigned u32x4 __attribute__((ext_vector_type(4)));
typedef unsigned u32x2 __attribute__((ext_vector_type(2)));
constexpr int BM = 256, BK = 64, HALF = 128, HTB = HALF * BK * 2, STAGE_BYTES = 8 * HTB, NXCD = 8, WGM = 8;
__host__ __device__ __forceinline__ int lds_byte(int r, int c) { const int st = (r >> 4) * 2 + (c >> 5), rr = r & 15, cc = c & 31, ob = rr * 64 + cc * 2; return st * 1024 + (ob ^ (((ob >> 9) & 1) << 5)); }
__host__ __device__ __forceinline__ void stage_rc(int b, int& R, int& C) { const int st = b / 1024, sb = b % 1024, swz = sb ^ (((sb >> 9) & 1) << 5); R = (st >> 1) * 16 + swz / 64; C = (st & 1) * 32 + (swz % 64) / 2; }
__host__ __device__ __forceinline__ int perm32(int rho) { const int n = rho >> 4, i = rho & 15; return 8 * (i >> 2) + 4 * n + (i & 3); }
struct Unit { int pm, pn; };
struct Gemm { const bf16_t* A; const bf16_t* Bt; int M, N, K, lda, asplit, akoff; };
struct StaticOrder {
    int nM, nN, nwg, G, c;
    __host__ __device__ void init(int M, int N, int G_, int c_) { nM = M / BM; nN = N / BM; nwg = nM * nN; G = G_; c = c_; }
    __host__ __device__ bool next(int i, Unit& u) const {
        const long L = (long)i * G + c; if (L >= nwg) return false;
        int wgid = (int)L; { const int q = nwg / NXCD, r = nwg % NXCD, xcd = wgid % NXCD, off = wgid / NXCD; wgid = (xcd < r ? xcd * (q + 1) : r * (q + 1) + (xcd - r) * q) + off; }
        const int nig = WGM * nN, gid = wgid / nig, fm = gid * WGM, gsz = (nM - fm) < WGM ? (nM - fm) : WGM;
        u.pm = fm + ((wgid % nig) % gsz); u.pn = (wgid % nig) / gsz; return true;
    }
};
__device__ __forceinline__ unsigned cvt_pk_bf16(float lo, float hi) { unsigned r; asm volatile("v_cvt_pk_bf16_f32 %0, %1, %2" : "=v"(r) : "v"(lo), "v"(hi)); return r; }
__device__ __forceinline__ u32x4 pack8(const f32x4& a, const f32x4& b) { u32x4 w; w.x = cvt_pk_bf16(a[0], a[1]); w.y = cvt_pk_bf16(a[2], a[3]); w.z = cvt_pk_bf16(b[0], b[1]); w.w = cvt_pk_bf16(b[2], b[3]); return w; }

template <class Epi, bool ALIGN_EPI>
__device__ __forceinline__ void gemm_phase(PG8_LAS unsigned char* lds, const Gemm g, const StaticOrder& S, const Epi& E, const int tid) {
    const int wid = __builtin_amdgcn_readfirstlane(tid >> 6), lane = tid & 63, wr = wid >> 2, wc = wid & 3, fr = lane & 15, fq = lane >> 4;
    const int K = g.K, nt = K / BK, lda = g.lda;
    unsigned voffA[2], voffB[2];
#pragma unroll
    for (int i = 0; i < 2; ++i) { int R, C; stage_rc(tid * 16 + i * 8192, R, C); const int Rb = Epi::PERM ? ((R & ~31) + perm32(R & 31)) : R;
        voffA[i] = (unsigned)(R * lda + C) * 2u; voffB[i] = (unsigned)(Rb * K + C) * 2u; }
    const size_t kstep = (size_t)(BK * 2);
    const size_t hstepA = (size_t)HALF * lda * 2, tstepA = 2 * hstepA;
    const size_t hstepB = (size_t)HALF * K * 2, tstepB = 2 * hstepB;
    const unsigned ldsw = (unsigned)wid * 1024u;
    const int aoff = lds_byte(wr * 64 + fr, fq * 8), boff = lds_byte(wc * 32 + fr, fq * 8);
#define PG8_SA(b, h) (((b) * 2 + (h)) * HTB)
#define PG8_SB(b, h) ((4 + (b) * 2 + (h)) * HTB)
#define PG8_STAGE(bufoff, gbase, voff) do { _Pragma("unroll") for (int _i = 0; _i < 2; ++_i) \
        __builtin_amdgcn_global_load_lds((const unsigned*)((const char*)(gbase) + (voff)[_i]), (PG8_LAS unsigned*)(lds + (bufoff) + ldsw + _i * 8192), 16, 0, 0); } while (0)
#define PG8_LDA(dst, b, h) do { _Pragma("unroll") for (int m = 0; m < 4; ++m) _Pragma("unroll") for (int k = 0; k < 2; ++k) dst[m][k] = *(const PG8_LAS bf16x8*)(lds + PG8_SA(b, h) + aoff + m * 2048 + k * 1024); } while (0)
#define PG8_LDB(dst, b, h) do { _Pragma("unroll") for (int n = 0; n < 2; ++n) _Pragma("unroll") for (int k = 0; k < 2; ++k) dst[n][k] = *(const PG8_LAS bf16x8*)(lds + PG8_SB(b, h) + boff + n * 2048 + k * 1024); } while (0)
#define PG8_MMA(ai, bj, At, Bt) do { __builtin_amdgcn_s_setprio(1); _Pragma("unroll") for (int m = 0; m < 4; ++m) _Pragma("unroll") for (int n = 0; n < 2; ++n) _Pragma("unroll") for (int k = 0; k < 2; ++k) \
        acc[ai][bj][m][n] = __builtin_amdgcn_mfma_f32_16x16x32_bf16(Bt[n][k], At[m][k], acc[ai][bj][m][n], 0, 0, 0); __builtin_amdgcn_s_setprio(0); } while (0)
#define PG8_WAIT_V(n) asm volatile("s_waitcnt vmcnt(" #n ")" ::: "memory")
#define PG8_WAIT_L(n) asm volatile("s_waitcnt lgkmcnt(" #n ")" ::: "memory")
#define PG8_BAR __builtin_amdgcn_s_barrier()
#define PG8_SCHED __builtin_amdgcn_sched_barrier(0)
#define PG8_APTR(u) ((const char*)g.A + (size_t)(u).pm * tstepA + ((u).pn >= g.asplit ? (size_t)g.akoff * 2 : (size_t)0))
    Unit cur, nxt; int ui = 0;
    if (!S.next(0, cur)) return;
    f32x4 acc[2][2][4][2];
#pragma unroll
    for (int a = 0; a < 2; ++a)
#pragma unroll
        for (int b = 0; b < 2; ++b)
#pragma unroll
            for (int m = 0; m < 4; ++m)
#pragma unroll
                for (int n = 0; n < 2; ++n) acc[a][b][m][n] = (f32x4){0.f, 0.f, 0.f, 0.f};
    bf16x8 At[4][2], B0[2][2], B1[2][2];
    const char* cA = PG8_APTR(cur); const char* cB = (const char*)g.Bt + (size_t)cur.pn * tstepB;
    {
        PG8_STAGE(PG8_SB(0, 0), cB, voffB); PG8_STAGE(PG8_SB(0, 1), cB + hstepB, voffB); PG8_STAGE(PG8_SA(0, 0), cA, voffA); PG8_STAGE(PG8_SA(0, 1), cA + hstepA, voffA);
        if (wr == 1) PG8_BAR;
        PG8_WAIT_V(2); PG8_BAR;
        PG8_STAGE(PG8_SB(1, 0), cB + kstep, voffB); PG8_STAGE(PG8_SA(1, 0), cA + kstep, voffA); PG8_STAGE(PG8_SB(1, 1), cB + hstepB + kstep, voffB);
        PG8_WAIT_V(6); PG8_BAR;
    }
    for (;;) {
        const bool has_next = S.next(ui + 1, nxt);
        const char* nA = has_next ? PG8_APTR(nxt) : cA; const char* nB = has_next ? (const char*)g.Bt + (size_t)nxt.pn * tstepB : cB;
        for (int t = 0; t < nt; t += 2) {
            const bool last = (t == nt - 2);
            const char* a1 = cA + (size_t)(t + 1) * kstep;
            const char* a2 = last ? nA : cA + (size_t)(t + 2) * kstep; const char* b2 = last ? nB : cB + (size_t)(t + 2) * kstep;
            const char* a3 = a2 + kstep; const char* b3 = b2 + kstep;
            PG8_LDB(B0, 0, 0); PG8_LDB(B1, 0, 1); PG8_SCHED; PG8_LDA(At, 0, 0); PG8_STAGE(PG8_SA(1, 1), a1 + hstepA, voffA);
            PG8_WAIT_V(8); PG8_WAIT_L(0); PG8_BAR; PG8_MMA(0, 0, At, B0); PG8_MMA(0, 1, At, B1); PG8_BAR; PG8_SCHED;
            PG8_LDA(At, 0, 1); PG8_STAGE(PG8_SB(0, 0), b2, voffB); PG8_STAGE(PG8_SB(0, 1), b2 + hstepB, voffB); PG8_STAGE(PG8_SA(0, 0), a2, voffA);
            PG8_WAIT_V(8); PG8_WAIT_L(0); PG8_BAR; PG8_MMA(1, 0, At, B0); PG8_MMA(1, 1, At, B1); PG8_BAR; PG8_SCHED;
            PG8_LDB(B0, 1, 0); PG8_LDB(B1, 1, 1); PG8_SCHED; PG8_LDA(At, 1, 0); PG8_STAGE(PG8_SA(0, 1), a2 + hstepA, voffA);
            PG8_WAIT_V(8); PG8_WAIT_L(0); PG8_BAR; PG8_MMA(0, 0, At, B0); PG8_MMA(0, 1, At, B1); PG8_BAR; PG8_SCHED;
            PG8_LDA(At, 1, 1); PG8_STAGE(PG8_SB(1, 0), b3, voffB); PG8_STAGE(PG8_SB(1, 1), b3 + hstepB, voffB); PG8_STAGE(PG8_SA(1, 0), a3, voffA);
            PG8_WAIT_V(8); PG8_WAIT_L(0); PG8_BAR; PG8_MMA(1, 0, At, B0); PG8_MMA(1, 1, At, B1); PG8_BAR; PG8_SCHED;
        }
        if constexpr (ALIGN_EPI) { if (wr == 0) PG8_BAR; }
        { int fr_ = fr, fq_ = fq; asm volatile("" : "+v"(fr_), "+v"(fq_)); E(acc, cur, wr, wc, fr_, fq_); }
        if (!has_next) break;
#pragma unroll
        for (int a = 0; a < 2; ++a)
#pragma unroll
            for (int b = 0; b < 2; ++b)
#pragma unroll
                for (int m = 0; m < 4; ++m)
#pragma unroll
                    for (int n = 0; n < 2; ++n) acc[a][b][m][n] = (f32x4){0.f, 0.f, 0.f, 0.f};
        cur = nxt; cA = nA; cB = nB; ++ui;
        if constexpr (ALIGN_EPI) { if (wr == 1) PG8_BAR; }
    }
    PG8_WAIT_V(0);
    if constexpr (!ALIGN_EPI) { if (wr == 0) PG8_BAR; }
    PG8_BAR;
#undef PG8_SA
#undef PG8_SB
#undef PG8_STAGE
#undef PG8_LDA
#undef PG8_LDB
#undef PG8_MMA
#undef PG8_WAIT_V
#undef PG8_WAIT_L
#undef PG8_BAR
#undef PG8_SCHED
#undef PG8_APTR
}
}

using pg8::f32x4; using pg8::u32x4; using pg8::u32x2;
typedef f32x4 AccT[2][2][4][2];
__device__ __forceinline__ float fq_sum(float v) {
    v += __builtin_bit_cast(float, __builtin_amdgcn_ds_swizzle(__builtin_bit_cast(int, v), 0x401f));
    auto rr = __builtin_amdgcn_permlane32_swap(__builtin_bit_cast(unsigned, v), __builtin_bit_cast(unsigned, v), false, false);
    return __builtin_bit_cast(float, rr[0]) + __builtin_bit_cast(float, rr[1]);
}
__device__ __forceinline__ void st16(bf16* p, u32x4 v) { *(u32x4*)p = v; }

struct EpiIn {
    static constexpr bool PERM = true;
    Ctx C;
    __device__ __forceinline__ void operator()(const AccT& acc, const pg8::Unit& u, int wr, int wc, int fr, int fq) const {
        const int tile = u.pn; const bool lat = u.pm < ML / 256; const int l = C.layer;
        if (tile < 4) {
            const bool isB = tile >= 2, qt = (tile & 1) == 0; const bool isq = qt, isk = !qt && wc < 2;
            const int hh = qt ? wc : (wc & 1);
            f32x4 gn[2][2];
            if (isB && !(!isq && !isk)) { const float* g = (isq ? C.p.q_norm_b : C.p.k_norm_b) + l * 64;
#pragma unroll
                for (int bj = 0; bj < 2; ++bj)
#pragma unroll
                    for (int n = 0; n < 2; ++n) gn[bj][n] = *(const f32x4*)(g + 32 * bj + 8 * fq + 4 * n); }
#pragma unroll
            for (int ai = 0; ai < 2; ++ai)
#pragma unroll
                for (int m = 0; m < 4; ++m) {
                    int r = u.pm * 256 + ai * 128 + wr * 64 + m * 16 + fr; asm volatile("" : "+v"(r)); const RowInfo ri = row_info(r);
                    f32x4 x[2][2];
#pragma unroll
                    for (int bj = 0; bj < 2; ++bj)
#pragma unroll
                        for (int n = 0; n < 2; ++n) x[bj][n] = acc[ai][bj][m][n];
                    if (isq || isk) {
                        if (isB) { float ss = 0.f;
#pragma unroll
                            for (int bj = 0; bj < 2; ++bj)
#pragma unroll
                                for (int n = 0; n < 2; ++n) ss += (x[bj][n][0] * x[bj][n][0] + x[bj][n][1] * x[bj][n][1]) + (x[bj][n][2] * x[bj][n][2] + x[bj][n][3] * x[bj][n][3]);
                            ss = fq_sum(ss);
                            const float rs = rsqrtf(ss * (1.f / 64.f) + RMS_EPS);
#pragma unroll
                            for (int bj = 0; bj < 2; ++bj)
#pragma unroll
                                for (int n = 0; n < 2; ++n) x[bj][n] = x[bj][n] * rs * gn[bj][n]; }
                        if (lat) { const int pos = fq < 2 ? (ri.t >> 6) : (ri.t & 63); const float2* tb = C.T64 + pos * 16 + 8 * (fq & 1);
#pragma unroll
                            for (int n = 0; n < 2; ++n) { const f32x4 cs0 = *(const f32x4*)(tb + 4 * n), cs1 = *(const f32x4*)(tb + 4 * n + 2);
                                const float cc[4] = {cs0[0], cs0[2], cs1[0], cs1[2]}, sn[4] = {cs0[1], cs0[3], cs1[1], cs1[3]};
#pragma unroll
                                for (int e = 0; e < 4; ++e) { const float x1 = x[0][n][e], x2 = x[1][n][e]; x[0][n][e] = x1 * cc[e] - x2 * sn[e]; x[1][n][e] = x1 * sn[e] + x2 * cc[e]; } } }
                    }
                    if (isq) { bf16* q = (isB ? C.QB() : C.QA()) + (size_t)r * 256 + hh * 64 + 8 * fq;
                        st16(q, pg8::pack8(x[0][0] * C2AB, x[0][1] * C2AB)); st16(q + 32, pg8::pack8(x[1][0] * C2AB, x[1][1] * C2AB)); }
                    else if (isk) { bf16* k = isB ? C.KB(ri.b, hh) : C.KA(ri.b, hh);
                        st16(k + kimg(ri.krow, 8 * fq), pg8::pack8(x[0][0], x[0][1])); st16(k + kimg(ri.krow, 32 + 8 * fq), pg8::pack8(x[1][0], x[1][1])); }
                    else { bf16* v = isB ? C.VB(ri.b, hh) : C.VA(ri.b, hh);
                        st16(v + vimg(ri.krow, 8 * fq), pg8::pack8(x[0][0], x[0][1])); st16(v + vimg(ri.krow, 32 + 8 * fq), pg8::pack8(x[1][0], x[1][1])); }
                    asm volatile("" ::: "memory");
                }
        } else if (tile == 4) {
#pragma unroll
            for (int ai = 0; ai < 2; ++ai)
#pragma unroll
                for (int m = 0; m < 4; ++m) {
                    int r = u.pm * 256 + ai * 128 + wr * 64 + m * 16 + fr; asm volatile("" : "+v"(r)); float ss = 0.f; bf16* o = C.AUP() + (size_t)r * 512 + 32 * wc + 8 * fq;
#pragma unroll
                    for (int bj = 0; bj < 2; ++bj) { const f32x4 a = acc[ai][bj][m][0], b = acc[ai][bj][m][1];
                        ss += (a[0] * a[0] + a[1] * a[1]) + (a[2] * a[2] + a[3] * a[3]) + (b[0] * b[0] + b[1] * b[1]) + (b[2] * b[2] + b[3] * b[3]);
                        st16(o + 128 * bj, pg8::pack8(a, b)); }
                    ss = fq_sum(ss);
                    if (fq == 0) C.SSQ[(size_t)r * 8 + wc] = ss;
                }
        } else {
#pragma unroll
            for (int ai = 0; ai < 2; ++ai)
#pragma unroll
                for (int m = 0; m < 4; ++m) {
                    int r = u.pm * 256 + ai * 128 + wr * 64 + m * 16 + fr; asm volatile("" : "+v"(r)); const RowInfo ri = row_info(r); bf16* o = C.AUP() + (size_t)r * 512 + 256 + 32 * wc + 8 * fq;
                    const f32x4 a = acc[ai][0][m][0], b = acc[ai][0][m][1];
                    float ss = (a[0] * a[0] + a[1] * a[1]) + (a[2] * a[2] + a[3] * a[3]) + (b[0] * b[0] + b[1] * b[1]) + (b[2] * b[2] + b[3] * b[3]);
                    st16(o, pg8::pack8(a, b)); { unsigned z = 0u; asm volatile("" : "+v"(z)); st16(o + 128, (u32x4){z, z, z, z}); }
                    ss = fq_sum(ss);
                    if (fq == 0) C.SSQ[(size_t)r * 8 + 4 + wc] = ss;
                    if (wc == 0) {
                        f32x4 x1 = acc[ai][1][m][0], x2 = acc[ai][1][m][1];
                        if (lat) { const int pos = fq < 2 ? (ri.t >> 6) : (ri.t & 63); const float2* tb = C.T32 + pos * 8 + 4 * (fq & 1);
                            const f32x4 cs0 = *(const f32x4*)(tb), cs1 = *(const f32x4*)(tb + 2); const float cc[4] = {cs0[0], cs0[2], cs1[0], cs1[2]}, sn[4] = {cs0[1], cs0[3], cs1[1], cs1[3]};
#pragma unroll
                            for (int e = 0; e < 4; ++e) { const float p = x1[e], q = x2[e]; x1[e] = p * cc[e] - q * sn[e]; x2[e] = p * sn[e] + q * cc[e]; } }
                        bf16* k = C.KR(ri.b);
                        *(u32x2*)(k + krimg(ri.krow, 4 * fq)) = (u32x2){pg8::cvt_pk_bf16(x1[0], x1[1]), pg8::cvt_pk_bf16(x1[2], x1[3])};
                        *(u32x2*)(k + krimg(ri.krow, 16 + 4 * fq)) = (u32x2){pg8::cvt_pk_bf16(x2[0], x2[1]), pg8::cvt_pk_bf16(x2[2], x2[3])};
                    }
                    asm volatile("" ::: "memory");
                }
        }
    }
};
struct EpiUp {
    static constexpr bool PERM = true;
    Ctx C;
    __device__ __forceinline__ void operator()(const AccT& acc, const pg8::Unit& u, int wr, int wc, int fr, int fq) const {
        const int tile = u.pn; const bool lat = u.pm < ML / 256;
#pragma unroll
        for (int ai = 0; ai < 2; ++ai)
#pragma unroll
            for (int m = 0; m < 4; ++m) {
                int r = u.pm * 256 + ai * 128 + wr * 64 + m * 16 + fr; asm volatile("" : "+v"(r)); const RowInfo ri = row_info(r);
                const f32x4 s0 = *(const f32x4*)(C.SSQ + (size_t)r * 8), s1 = *(const f32x4*)(C.SSQ + (size_t)r * 8 + 4);
                if (tile < 3) {
                    const float sc = rsqrtf(((s0[0] + s0[1]) + (s0[2] + s0[3])) * (1.f / 256.f) + RMS_EPS) * C2C;
                    if (tile < 2) { bf16* q = C.QC() + (size_t)r * 768 + (4 * tile + wc) * 96 + 8 * fq;
                        st16(q, pg8::pack8(acc[ai][0][m][0] * sc, acc[ai][0][m][1] * sc)); st16(q + 32, pg8::pack8(acc[ai][1][m][0] * sc, acc[ai][1][m][1] * sc)); }
                    else { bf16* q = C.QC() + (size_t)r * 768 + (2 * wc + (fq >> 1)) * 96 + 64 + 8 * (fq & 1);
                        const int pos = (fq & 1) == 0 ? (ri.t >> 6) : (ri.t & 63); const float2* tb = C.T32 + pos * 8;
#pragma unroll
                        for (int n = 0; n < 2; ++n) { f32x4 x1 = acc[ai][0][m][n], x2 = acc[ai][1][m][n];
                            if (lat) { const f32x4 cs0 = *(const f32x4*)(tb + 4 * n), cs1 = *(const f32x4*)(tb + 4 * n + 2); const float cc[4] = {cs0[0], cs0[2], cs1[0], cs1[2]}, sn[4] = {cs0[1], cs0[3], cs1[1], cs1[3]};
#pragma unroll
                                for (int e = 0; e < 4; ++e) { const float p = x1[e], qq = x2[e]; x1[e] = p * cc[e] - qq * sn[e]; x2[e] = p * sn[e] + qq * cc[e]; } }
                            x1 = x1 * sc; x2 = x2 * sc;
                            *(u32x2*)(q + 4 * n) = (u32x2){pg8::cvt_pk_bf16(x1[0], x1[1]), pg8::cvt_pk_bf16(x1[2], x1[3])};
                            *(u32x2*)(q + 16 + 4 * n) = (u32x2){pg8::cvt_pk_bf16(x2[0], x2[1]), pg8::cvt_pk_bf16(x2[2], x2[3])};
                            asm volatile("" ::: "memory"); } }
                } else {
                    const float sc = rsqrtf(((s1[0] + s1[1]) + (s1[2] + s1[3])) * (1.f / 128.f) + RMS_EPS);
                    const bool isk = tile < 5; const int h = 4 * ((tile - 3) & 1) + wc; bf16* o = isk ? C.KC(ri.b, h) : C.VC(ri.b, h);
                    const size_t o0 = isk ? kimg(ri.krow, 8 * fq) : vimg(ri.krow, 8 * fq), o1 = isk ? kimg(ri.krow, 32 + 8 * fq) : vimg(ri.krow, 32 + 8 * fq);
                    st16(o + o0, pg8::pack8(acc[ai][0][m][0] * sc, acc[ai][0][m][1] * sc)); st16(o + o1, pg8::pack8(acc[ai][1][m][0] * sc, acc[ai][1][m][1] * sc));
                }
                asm volatile("" ::: "memory");
            }
    }
};
struct EpiRes {
    static constexpr bool PERM = false;
    Ctx C; int which_gate; bool first;
    __device__ __forceinline__ void operator()(const AccT& acc, const pg8::Unit& u, int wr, int wc, int fr, int fq) const {
        const int set = u.pm < 32 ? 0 : (u.pm < 64 ? 1 : 2); const float* g = C.mod(set, which_gate); const int col0 = u.pn * 256 + wc * 32 + 4 * fq;
        f32x4 gv[2][2];
#pragma unroll
        for (int bj = 0; bj < 2; ++bj)
#pragma unroll
            for (int n = 0; n < 2; ++n) gv[bj][n] = *(const f32x4*)(g + col0 + bj * 128 + n * 16);
#pragma unroll
        for (int ai = 0; ai < 2; ++ai)
#pragma unroll
            for (int m = 0; m < 4; ++m) {
                int r = u.pm * 256 + ai * 128 + wr * 64 + m * 16 + fr; asm volatile("" : "+v"(r)); const float* base = (first ? C.resid_in(r) : C.resid(r)) + col0; float* o = C.resid(r) + col0;
#pragma unroll
                for (int bj = 0; bj < 2; ++bj)
#pragma unroll
                    for (int n = 0; n < 2; ++n) { const f32x4 bs = *(const f32x4*)(base + bj * 128 + n * 16); *(f32x4*)(o + bj * 128 + n * 16) = bs * ALPHA + gv[bj][n] * acc[ai][bj][m][n]; }
            }
    }
};
struct EpiRelu2 {
    static constexpr bool PERM = true;
    bf16* O;
    __device__ __forceinline__ void operator()(const AccT& acc, const pg8::Unit& u, int wr, int wc, int fr, int fq) const {
#pragma unroll
        for (int ai = 0; ai < 2; ++ai)
#pragma unroll
            for (int m = 0; m < 4; ++m) { int r = u.pm * 256 + ai * 128 + wr * 64 + m * 16 + fr; asm volatile("" : "+v"(r)); bf16* rowp = O + (size_t)r * DFF + u.pn * 256 + wc * 32 + 8 * fq;
#pragma unroll
                for (int bj = 0; bj < 2; ++bj) { f32x4 a = acc[ai][bj][m][0], b = acc[ai][bj][m][1];
#pragma unroll
                    for (int e = 0; e < 4; ++e) { const float p = fmaxf(a[e], 0.f), q = fmaxf(b[e], 0.f); a[e] = p * p; b[e] = q * q; }
                    st16(rowp + bj * 128, pg8::pack8(a, b)); } }
    }
};

__device__ __forceinline__ int win_src(int n) {
    const int tile = n >> 8, c = n & 255, bj = c >> 7, wc = (c >> 5) & 3, d = 32 * bj + (c & 31);
    switch (tile) {
        case 0: return wc * 64 + d;
        case 1: return (wc < 2 ? 256 + wc * 64 : 384 + (wc - 2) * 64) + d;
        case 2: return 512 + wc * 64 + d;
        case 3: return (wc < 2 ? 768 + wc * 64 : 896 + (wc - 2) * 64) + d;
        case 4: return 1024 + c;
        default: if (c < 128) return 1280 + c; if (c < 160) { const int e = (c - 128) & 7, fq = (c - 128) >> 3; return 1408 + (e < 4 ? 4 * fq + e : 16 + 4 * fq + (e - 4)); } return -1;
    }
}
__device__ __forceinline__ int wuq_src(int n) {
    const int tile = n >> 8, c = n & 255, bj = c >> 7, wc = (c >> 5) & 3, i = c & 31;
    if (tile < 2) return (4 * tile + wc) * 96 + 32 * bj + i;
    return (2 * wc + (i >> 4)) * 96 + 64 + 16 * bj + (i & 15);
}
__device__ __forceinline__ int wukv_src(int n) {
    const int tile = n >> 8, c = n & 255, bj = c >> 7, wc = (c >> 5) & 3, i = c & 31;
    return (4 * tile + wc) * 64 + 32 * bj + i;
}
__device__ __forceinline__ void conv_item(const float* W, int Ks, int Ns, bf16* WT, int Kd, int row_off, int mode, const float* kscale, __attribute__((address_space(3))) float* scr, int kb, int nb, int lane) {
    const int k0 = 64 * kb, n0 = 32 * nb; const int nn = n0 + (lane & 31);
    const int sc = mode == 0 ? nn : mode == 1 ? win_src(nn) : mode == 2 ? wuq_src(nn) : wukv_src(nn);
#pragma unroll 8
    for (int i = 0; i < 32; ++i) { const int kk = 2 * i + (lane >> 5), k = k0 + kk; float v = 0.f; if (sc >= 0 && k < Ks) { v = W[(size_t)k * Ns + sc]; if (kscale) v *= kscale[k]; } scr[kk * 33 + (lane & 31)] = v; }
    asm volatile("s_waitcnt lgkmcnt(0)" ::: "memory");
    const int c = lane & 7;
#pragma unroll
    for (int j = 0; j < 4; ++j) { const int n = (lane >> 3) + 8 * j; const __attribute__((address_space(3))) float* s = scr + (8 * c) * 33 + n;
        u32x4 o; o.x = f2bf(s[0]) | (f2bf(s[33]) << 16); o.y = f2bf(s[66]) | (f2bf(s[99]) << 16); o.z = f2bf(s[132]) | (f2bf(s[165]) << 16); o.w = f2bf(s[198]) | (f2bf(s[231]) << 16);
        *(u32x4*)(WT + (size_t)(row_off + n0 + n) * Kd + k0 + 8 * c) = o; }
    asm volatile("s_waitcnt lgkmcnt(0)" ::: "memory");
}
__device__ __forceinline__ bf16* wts(const Params& p, int l, size_t off) { return (bf16*)(p.ws + WS_W + (size_t)l * W_LAYER + off); }
__device__ __forceinline__ void ph_prologue(const Ctx& C, unsigned char* ldsb) {
    const Params& p = C.p; const int tid = C.tid(), lane = tid & 63, wave = C.wave;
    { float* red = (float*)ldsb;
      for (int task = obid(); task < DEPTH * (DMOD / 64); task += ogrid()) {
        const int l = task / (DMOD / 64), n = (task % (DMOD / 64)) * 64 + lane; const float* w = p.w_mod + (size_t)l * D * DMOD + n;
        float a0 = 0.f, a1 = 0.f, a2 = 0.f;
#pragma unroll 8
        for (int kk = 0; kk < 128; ++kk) { const int k = wave * 128 + kk; const float wv = w[(size_t)k * DMOD];
            a0 += nv::silu(p.c[k]) * wv; a1 += nv::silu(p.c[D + k]) * wv; a2 += nv::silu(p.c_ctx[k]) * wv; }
        __syncthreads();
        red[(wave * 3 + 0) * 64 + lane] = a0; red[(wave * 3 + 1) * 64 + lane] = a1; red[(wave * 3 + 2) * 64 + lane] = a2;
        __syncthreads();
        if (tid < 192) { const int s = tid >> 6; float acc = p.b_mod[l * DMOD + n];
#pragma unroll
            for (int wv = 0; wv < 8; ++wv) acc += red[(wv * 3 + s) * 64 + lane];
            C.MOD[(size_t)(l * 3 + s) * DMOD + n] = acc; }
      }
      __syncthreads();
    }
    const int gtid = obid() * NTHREADS + tid, gsz = ogrid() * NTHREADS;
    for (int idx = gtid; idx < 128 * 16; idx += gsz) { const int pos = idx >> 4, j = idx & 15; const float inv = powf(10000.f, -(float)j / 16.f), a = (float)pos * inv; C.T64[idx] = make_float2(cosf(a), sinf(a)); }
    for (int idx = gtid; idx < 128 * 8; idx += gsz) { const int pos = idx >> 3, j = idx & 7; const float inv = powf(10000.f, -(float)j / 8.f), a = (float)pos * inv; C.T32[idx] = make_float2(cosf(a), sinf(a)); }
    __attribute__((address_space(3))) float* scr = (__attribute__((address_space(3))) float*)(ldsb) + wave * (64 * 33);
    const int gw = obid() * (NTHREADS / 64) + wave, ngw = ogrid() * (NTHREADS / 64);
    constexpr int I_IN = 16 * 48, I_UQ = 4 * 24, I_UKV = 4 * 16, I_OUT = 16 * 32, I_FC1 = 16 * 128, I_FC2 = 64 * 32;
    constexpr int I_L = I_IN + I_UQ + 2 * I_UKV + I_OUT + I_FC1 + I_FC2;
    for (int it = gw; it < DEPTH * I_L; it += ngw) {
        const int l = it / I_L; int r = it % I_L;
        if (r < I_IN) { conv_item(p.w_in + (size_t)l * D * DIN, D, DIN, wts(p, l, W_IN), D, 0, 1, nullptr, scr, r / 48, r % 48, lane); continue; } r -= I_IN;
        if (r < I_UQ) { conv_item(p.w_uq + (size_t)l * 256 * 768, 256, 768, wts(p, l, W_UP), 256, 0, 2, p.mla_q_norm + l * 256, scr, r / 24, r % 24, lane); continue; } r -= I_UQ;
        if (r < I_UKV) { conv_item(p.w_uk + (size_t)l * 128 * 512, 128, 512, wts(p, l, W_UP), 256, 768, 3, p.mla_kv_norm + l * 128, scr, r / 16, r % 16, lane); continue; } r -= I_UKV;
        if (r < I_UKV) { conv_item(p.w_uv + (size_t)l * 128 * 512, 128, 512, wts(p, l, W_UP), 256, 1280, 3, p.mla_kv_norm + l * 128, scr, r / 16, r % 16, lane); continue; } r -= I_UKV;
        if (r < I_OUT) { conv_item(p.w_out + (size_t)l * D * D, D, D, wts(p, l, W_OUT), D, 0, 0, nullptr, scr, r / 32, r % 32, lane); continue; } r -= I_OUT;
        if (r < I_FC1) { conv_item(p.w_fc1 + (size_t)l * D * DFF, D, DFF, wts(p, l, W_FC1), D, 0, 0, nullptr, scr, r / 128, r % 128, lane); continue; } r -= I_FC1;
        conv_item(p.w_fc2 + (size_t)l * DFF * D, DFF, D, wts(p, l, W_FC2), DFF, 0, 0, nullptr, scr, r / 32, r % 32, lane);
    }
}


#define LAS __attribute__((address_space(3)))
constexpr int RING_BYTES = 131072, LDSCTL_OFF = RING_BYTES, MISC_OFF = LDSCTL_OFF + 320, LDS_BYTES = 147456;
constexpr int CW_BAR = 4096;
#define XB_TMO      128
#define XB_XCNT(j)  (256  + 64 * (j))
#define XB_XSUB(j)  (1280 + 64 * (j))
#define XB_XGEN(j)  (2304 + 64 * (j))
#define XB_TOP      3328
#define XB_TOPGEN   3392
#define XB_SPIN_CAP (1u << 20)
__device__ __forceinline__ unsigned xb_ld(unsigned* p)              { return __hip_atomic_load(p, __ATOMIC_RELAXED, __HIP_MEMORY_SCOPE_AGENT); }
__device__ __forceinline__ unsigned xb_add(unsigned* p, unsigned v) { return __hip_atomic_fetch_add(p, v, __ATOMIC_RELAXED, __HIP_MEMORY_SCOPE_AGENT); }
__device__ __forceinline__ unsigned xb_xcc_id() { return (unsigned)__builtin_amdgcn_s_getreg((3 << 11) | 20) & 0xFu; }
#define XB_SPIN(cond, bar) do { unsigned _sp = 0; while (cond) { __builtin_amdgcn_s_sleep(1); \
    if ((++_sp & 255u) == 0u) { if (xb_ld(&(bar)[XB_TMO])) break; if (_sp > XB_SPIN_CAP) { atomicAdd(&(bar)[XB_TMO], 1u); break; } } } } while (0)
struct XcdBarrier { unsigned* bar; unsigned x; volatile LAS unsigned* st; };
__device__ __forceinline__ XcdBarrier xcd_barrier_post(unsigned* bar, volatile LAS unsigned* st, int tid) {
    XcdBarrier b; b.bar = bar; b.x = 0; b.st = st;
    if (tid == 0) (void)xb_add(&bar[XB_XCNT(__builtin_amdgcn_readfirstlane(xb_xcc_id()))], 1u);
    return b;
}
__device__ __forceinline__ void xcd_barrier_complete(unsigned* bar, unsigned x, unsigned& nloc, unsigned& nx) {
    const unsigned G = gridDim.x * gridDim.y * gridDim.z;
    unsigned sum, cnt, mine, sp = 0u;
    for (;;) {
        sum = 0u; cnt = 0u; mine = 0u;
#pragma unroll
        for (unsigned j = 0; j < 16; ++j) { const unsigned c = xb_ld(&bar[XB_XCNT(j)]); sum += c; cnt += (c > 0u) ? 1u : 0u; mine = (j == x) ? c : mine; }
        if (sum == G) break;
        __builtin_amdgcn_s_sleep(1);
        if ((++sp & 255u) == 0u) { if (xb_ld(&bar[XB_TMO])) break; if (sp > XB_SPIN_CAP) { atomicAdd(&bar[XB_TMO], 1u); break; } }
    }
    nloc = mine > 0u ? mine : 1u; nx = cnt > 0u ? cnt : 1u;
}
__device__ __forceinline__ void xcd_barrier(const XcdBarrier& b, int tid) {
    asm volatile("s_waitcnt vmcnt(0)" ::: "memory");
    __syncthreads();
    if (tid == 0) {
        unsigned* bar = b.bar; const unsigned bx = (unsigned)__builtin_amdgcn_readfirstlane(xb_xcc_id());
        __builtin_amdgcn_s_waitcnt(0);
        unsigned nloc = b.st[0], nx = b.st[1];
        if (nloc == 0u) { xcd_barrier_complete(bar, bx, nloc, nx); b.st[0] = nloc; b.st[1] = nx; }
        const unsigned old = xb_add(&bar[XB_XSUB(bx)], 1u);
        const unsigned gen = old / nloc;
        if (old + 1u == (gen + 1u) * nloc) {
            __builtin_amdgcn_fence(__ATOMIC_RELEASE, "agent");
            asm volatile("s_waitcnt vmcnt(0)" ::: "memory");
            const unsigned og = xb_add(&bar[XB_TOP], 1u);
            const unsigned tg = og / nx;
            if (og + 1u == (tg + 1u) * nx) xb_add(&bar[XB_TOPGEN], 1u);
            else XB_SPIN(xb_ld(&bar[XB_TOPGEN]) == tg, bar);
            __builtin_amdgcn_fence(__ATOMIC_ACQUIRE, "agent");
            xb_add(&bar[XB_XGEN(bx)], 1u);
            asm volatile("s_waitcnt vmcnt(0)" ::: "memory");
        } else {
            XB_SPIN(xb_ld(&bar[XB_XGEN(bx)]) == gen, bar);
            __builtin_amdgcn_fence(__ATOMIC_ACQUIRE, "agent");
            asm volatile("s_waitcnt vmcnt(0)" ::: "memory");
        }
    }
    __syncthreads();
}


namespace fa {
typedef short bf16x8 __attribute__((ext_vector_type(8)));
typedef short s16x4 __attribute__((ext_vector_type(4)));
typedef short v4i16_t __attribute__((ext_vector_type(4)));
typedef float f32x16 __attribute__((ext_vector_type(16)));
typedef float f32x2_t __attribute__((ext_vector_type(2))); typedef __bf16 bf16x2_t __attribute__((ext_vector_type(2)));
constexpr int KBUF = 12288, VBUF = 8192, BUFB = KBUF + VBUF, OFF_WS = 2 * BUFB, OFF_OST = OFF_WS + 8 * 256, LDS_TOTAL = OFF_OST + 8 * 4096;
static_assert(LDS_TOTAL <= RING_BYTES, "attention LDS");
constexpr float THR = 8.f;
__device__ __forceinline__ int crow(int r, int hi) { return (r & 3) + 8 * (r >> 2) + 4 * hi; }
__device__ __forceinline__ unsigned cvtpk(float lo, float hi) { f32x2_t v = {lo, hi}; bf16x2_t b = __builtin_convertvector(v, bf16x2_t); return __builtin_bit_cast(unsigned, b); }
__device__ __forceinline__ s16x4 vtr(const LAS unsigned char* p) { return __builtin_bit_cast(s16x4, __builtin_amdgcn_ds_read_tr16_b64_v4i16((LAS v4i16_t*)p)); }
__device__ __forceinline__ float swap_max(float m) { auto rr = __builtin_amdgcn_permlane32_swap(__builtin_bit_cast(unsigned, m), __builtin_bit_cast(unsigned, m), false, false); return fmaxf(__builtin_bit_cast(float, rr[0]), __builtin_bit_cast(float, rr[1])); }
__device__ __forceinline__ float swap_sum(float m) { auto rr = __builtin_amdgcn_permlane32_swap(__builtin_bit_cast(unsigned, m), __builtin_bit_cast(unsigned, m), false, false); return __builtin_bit_cast(float, rr[0]) + __builtin_bit_cast(float, rr[1]); }

template <int DQK, bool MASK>
__device__ __forceinline__ void attn_unit(const Ctx& C, LAS unsigned char* lds, const int tid, const int type, const int b, const int h, const int row0, const int qpos0, const int tlo, const int thi) {
    constexpr int NCH = DQK / 8, ND0 = DQK / 16, NPIECE = NCH + 8;
    const int lane = tid & 63, wid = __builtin_amdgcn_readfirstlane(tid >> 6), r32 = lane & 31, hi = lane >> 5;
    const int kvh = type == 2 ? h : (h >> 1);
    const bf16* Kimg = type == 0 ? C.KA(b, kvh) : type == 1 ? C.KB(b, kvh) : C.KC(b, kvh);
    const bf16* Vimg = type == 0 ? C.VA(b, kvh) : type == 1 ? C.VB(b, kvh) : C.VC(b, kvh);
    const bf16* KRimg = C.KR(b);
    const int qrow = row0 + wid * 32 + r32;
    const bf16* Q = type == 0 ? C.QA() + (size_t)qrow * 256 + h * 64 : type == 1 ? C.QB() + (size_t)qrow * 256 + h * 64 : C.QC() + (size_t)qrow * 768 + h * 96;
    bf16x8 qr[ND0];
#pragma unroll
    for (int d0 = 0; d0 < ND0; ++d0) qr[d0] = *(const bf16x8*)(Q + 16 * d0 + 8 * hi);
    const int ntiles = 4 + (thi - tlo);
#define FA_ISSUE(tt, buf) do { _Pragma("unroll") for (int pi = 0; pi < 3; ++pi) { const int pc = wid + 8 * pi; if (pc < NPIECE) { \
        const bf16* srcp = pc < 8 ? Kimg + (size_t)(tt) * 4096 + pc * 512 : (pc < NCH ? KRimg + (size_t)(tt) * 2048 + (pc - 8) * 512 : Vimg + (size_t)(tt) * 4096 + (pc - NCH) * 512); \
        const int dsto = (buf) * BUFB + (pc < NCH ? pc * 1024 : KBUF + (pc - NCH) * 1024); \
        __builtin_amdgcn_global_load_lds((const unsigned*)(srcp + lane * 8), (LAS unsigned*)(lds + dsto), 16, 0, 0); } } } while (0)
    f32x16 o[2]; o[0] = f32x16{}; o[1] = f32x16{};
    f32x16 negm = f32x16{};
    float mhat = 0.f, lsum = 0.f;
    LAS float* wsf = (LAS float*)(lds + OFF_WS) + wid * 64;
    const int vlane = ((lane >> 4) & 1) * 32 + (lane & 3) * 8 + (4 * hi + ((lane & 15) >> 2)) * 64;
    const int qpos = qpos0 + wid * 32 + r32;
    FA_ISSUE(0, 0);
    for (int i = 0; i < ntiles; ++i) {
        const int tcur = i < 4 ? i : tlo + (i - 4);
        __syncthreads();
        if (i + 1 < ntiles) { const int tn = (i + 1) < 4 ? (i + 1) : tlo + (i - 3); FA_ISSUE(tn, (i + 1) & 1); }
        const LAS unsigned char* kb = lds + (i & 1) * BUFB + hi * 1024 + r32 * 16;
        const LAS unsigned char* vb = lds + (i & 1) * BUFB + KBUF + vlane;
        f32x16 p0, p1;
#pragma unroll
        for (int d0 = 0; d0 < ND0; ++d0) {
            const bf16x8 k0 = *(const LAS bf16x8*)(kb + d0 * 2048), k1 = *(const LAS bf16x8*)(kb + d0 * 2048 + 512);
            if (d0 == 0) { p0 = __builtin_amdgcn_mfma_f32_32x32x16_bf16(k0, qr[0], negm, 0, 0, 0); p1 = __builtin_amdgcn_mfma_f32_32x32x16_bf16(k1, qr[0], negm, 0, 0, 0); }
            else { p0 = __builtin_amdgcn_mfma_f32_32x32x16_bf16(k0, qr[d0], p0, 0, 0, 0); p1 = __builtin_amdgcn_mfma_f32_32x32x16_bf16(k1, qr[d0], p1, 0, 0, 0); }
        }
        if (MASK && tcur >= 4) { const int rel0 = (tcur - 4) * 64 + 4 * hi - qpos;
#pragma unroll
            for (int r = 0; r < 16; ++r) { const int rel = rel0 + (r & 3) + 8 * (r >> 2); if (rel > 128 || rel < -128) p0[r] = -INFINITY; if (rel + 32 > 128 || rel + 32 < -128) p1[r] = -INFINITY; } }
        float rm = fmaxf(p0[0], p1[0]);
#pragma unroll
        for (int r = 1; r < 16; ++r) rm = fmaxf(rm, fmaxf(p0[r], p1[r]));
        rm = swap_max(rm);
        const bool first = (i == 0);
        if (first || __any(rm > THR)) {
            const float dl = first ? rm : fmaxf(rm, 0.f);
            mhat += dl;
#pragma unroll
            for (int r = 0; r < 16; ++r) { p0[r] -= dl; p1[r] -= dl; }
#pragma unroll
            for (int r = 0; r < 16; ++r) negm[r] = -mhat;
            if (!first) { const float f = __builtin_amdgcn_exp2f(-dl); lsum *= f; if (hi == 0) wsf[r32] = f;
#pragma unroll
                for (int r = 0; r < 16; ++r) { const float fr_ = wsf[crow(r, hi)]; o[0][r] *= fr_; o[1][r] *= fr_; } }
        }
        float sacc = 0.f;
#pragma unroll
        for (int r = 0; r < 16; ++r) { p0[r] = __builtin_amdgcn_exp2f(p0[r]); p1[r] = __builtin_amdgcn_exp2f(p1[r]); sacc += p0[r] + p1[r]; }
        lsum += sacc;
        u32x4 pw[4];
#pragma unroll
        for (int j = 0; j < 4; ++j) { pw[0][j] = cvtpk(p0[2 * j], p0[2 * j + 1]); pw[1][j] = cvtpk(p0[8 + 2 * j], p0[9 + 2 * j]); pw[2][j] = cvtpk(p1[2 * j], p1[2 * j + 1]); pw[3][j] = cvtpk(p1[8 + 2 * j], p1[9 + 2 * j]); }
#pragma unroll
        for (int d0 = 0; d0 < 2; ++d0)
#pragma unroll
            for (int ks = 0; ks < 4; ++ks) {
                const s16x4 lo = vtr(vb + d0 * 4096 + ks * 1024), hh = vtr(vb + d0 * 4096 + ks * 1024 + 512);
                const bf16x8 vf = (bf16x8){lo[0], lo[1], lo[2], lo[3], hh[0], hh[1], hh[2], hh[3]};
                o[d0] = __builtin_amdgcn_mfma_f32_32x32x16_bf16(__builtin_bit_cast(bf16x8, pw[ks]), vf, o[d0], 0, 0, 0);
            }
    }
#undef FA_ISSUE
    float ltot = swap_sum(lsum);
    if (type == 0) ltot += __builtin_amdgcn_exp2f(C.p.sink_a[C.layer * 4 + h] * LOG2E - mhat);
    if (hi == 0) wsf[32 + r32] = 1.f / ltot;
    LAS unsigned short* stg = (LAS unsigned short*)(lds + OFF_OST + wid * 4096);
#pragma unroll
    for (int r = 0; r < 16; ++r) { const int orow = crow(r, hi); const float rl = wsf[32 + orow];
        stg[orow * 64 + r32] = (unsigned short)f2bf(o[0][r] * rl); stg[orow * 64 + 32 + r32] = (unsigned short)f2bf(o[1][r] * rl); }
    bf16* Yw = C.Y() + (size_t)(row0 + wid * 32) * D + (type == 0 ? 0 : type == 1 ? 256 : 512) + h * 64;
#pragma unroll
    for (int i = 0; i < 4; ++i) { const int row = i * 8 + (lane >> 3), ch = lane & 7; const u32x4 v = *(const LAS u32x4*)(stg + row * 64 + ch * 8); *(u32x4*)(Yw + (size_t)row * D + ch * 8) = v; }
    __syncthreads();
}
__device__ __forceinline__ void run_unit(const Ctx& C, LAS unsigned char* lds, int tid, int type, int b, int h, int qb  ) {
    if (qb < 0) { const int row0 = ML + b * CTX;
        if (type == 2) attn_unit<96, false>(C, lds, tid, 2, b, h, row0, 0, 4, 4); else attn_unit<64, false>(C, lds, tid, type, b, h, row0, 0, 4, 4); return; }
    const int q0 = qb * 256, row0 = b * SEQ + q0;
    if (type == 2) attn_unit<96, false>(C, lds, tid, 2, b, h, row0, q0, 4, NTILE);
    else if (type == 1) attn_unit<64, false>(C, lds, tid, 1, b, h, row0, q0, 4, NTILE);
    else { int lo = q0 - 128, hi_ = q0 + 384; if (lo < 0) lo = 0; if (hi_ > SEQ) hi_ = SEQ; attn_unit<64, true>(C, lds, tid, 0, b, h, row0, q0, 4 + lo / 64, 4 + hi_ / 64); }
}
__device__ __forceinline__ void ph_attn(const Ctx& C, LAS unsigned char* lds, int tid, bool with_ctx) {
    const int G = ogrid(), bx = obid();
    const int v = (G % 8 == 0) ? (bx % 8) * (G / 8) + bx / 8 : bx;
    for (int u = v; u < 256; u += G) {
        for (int i = 0; i < 2; ++i) { const int uc = 2 * u + i, pair = uc >> 5; run_unit(C, lds, tid, 2, pair >> 3, pair & 7, uc & 31); }
        run_unit(C, lds, tid, 1, u >> 7, (u >> 5) & 3, u & 31);
        run_unit(C, lds, tid, 0, u >> 7, (u >> 5) & 3, u & 31);
        if (with_ctx && (u & 7) == 0) { const int j = u >> 3;
            if (j < 8) run_unit(C, lds, tid, 0, j >> 2, j & 3, -1); else if (j < 16) run_unit(C, lds, tid, 1, (j - 8) >> 2, j & 3, -1); else run_unit(C, lds, tid, 2, (j - 16) >> 3, j & 7, -1); }
    }
}
}

__device__ __forceinline__ Ctx make_ctx(int layer, int wave) {
    typedef __attribute__((address_space(4))) const unsigned long long kw_t;
    kw_t* kp = (kw_t*)__builtin_amdgcn_kernarg_segment_ptr();
    asm volatile("" : "+s"(kp));
    Ctx C; unsigned long long* d = (unsigned long long*)&C.p;
#pragma unroll
    for (int i = 0; i < (int)(sizeof(Params) / 8); ++i) d[i] = (unsigned long long)(uintptr_t)(void*)(__attribute__((address_space(1))) void*)(uintptr_t)kp[i];
    C.layer = layer; C.wave = wave; unsigned char* ws = C.p.ws;
    C.MOD = (float*)(ws + WS_MOD); C.T64 = (float2*)(ws + WS_T64); C.T32 = (float2*)(ws + WS_T32); C.SSQ = (float*)(ws + WS_SSQ);
    C.RC = (float*)(ws + WS_RC); C.H = (bf16*)(ws + WS_H); C.R = ws + WS_R;
    return C;
}
__global__ void __launch_bounds__(NTHREADS, 2) fwd_kernel(Params p_unused) {
    extern __shared__ __attribute__((aligned(16))) unsigned char lds[];
    cg::grid_group grid = cg::this_grid();
    const int wave_s = __builtin_amdgcn_readfirstlane(threadIdx.x >> 6);
    const int gsz = ogrid() * NTHREADS;
#define TID otid(wave_s)
#define GTID ((int)(obid() * NTHREADS) + otid(wave_s))
#define CTX(l) make_ctx((l), wave_s)
    for (int u = threadIdx.x; u < (LDS_BYTES - LDSCTL_OFF) / 4; u += NTHREADS) ((LAS unsigned*)((LAS unsigned char*)lds + LDSCTL_OFF))[u] = 0u;
    __syncthreads();
    XcdBarrier bar;
    { const Ctx C = CTX(0); bar = xcd_barrier_post((unsigned*)(C.p.ws + WS_CTL) + CW_BAR, (volatile LAS unsigned*)((LAS unsigned char*)lds + MISC_OFF) + 8, TID); }
#define SEAM() xcd_barrier(bar, TID)
#ifndef SKIP_PRO
    { const Ctx C = CTX(0); ph_prologue(C, lds); }
#endif
    grid.sync();
    { const Ctx C = CTX(0); nv::ph_modulate(C, GTID, gsz, MA); }
    SEAM();
    pg8::PG8_LAS_T ring = (pg8::PG8_LAS_T)lds;
    for (int l = 0; l < DEPTH; ++l) {
        const bool last = l == DEPTH - 1; const int nrows = last ? ML : MA;
#ifndef SKIP_IN
        { const Ctx C = CTX(l); pg8::Gemm g{C.H, wts(C.p, l, W_IN), MA, 1536, D, D, 1 << 30, 0}; pg8::StaticOrder S; S.init(MA, 1536, ogrid(), obid()); EpiIn E{C}; pg8::gemm_phase<EpiIn, true>(ring, g, S, E, TID); }
#endif
        SEAM();
#ifndef SKIP_UP
        { const Ctx C = CTX(l); pg8::Gemm g{C.AUP(), wts(C.p, l, W_UP), MA, 1792, 256, 512, 3, 256}; pg8::StaticOrder S; S.init(MA, 1792, ogrid(), obid()); EpiUp E{C}; pg8::gemm_phase<EpiUp, true>(ring, g, S, E, TID); }
#endif
        SEAM();
#ifndef SKIP_ATT
#ifdef NAIVE_ATT
        { const Ctx C = CTX(l); nv::ph_attn(C, (float*)lds, !last); }
#else
        { const Ctx C = CTX(l); fa::ph_attn(C, (LAS unsigned char*)lds, TID, !last); }
#endif
#endif
        SEAM();
#ifndef SKIP_OUT
        { const Ctx C = CTX(l); pg8::Gemm g{C.Y(), wts(C.p, l, W_OUT), nrows, D, D, D, 1 << 30, 0}; pg8::StaticOrder S; S.init(nrows, D, ogrid(), obid()); EpiRes E{C, 2, true}; pg8::gemm_phase<EpiRes, true>(ring, g, S, E, TID); }
#endif
        SEAM();
        { const Ctx C = CTX(l); ph_ln(C, nrows, C.p.ln1_g + l * D, C.p.ln1_b + l * D, true, l, 3, nullptr); }
        SEAM();
#ifndef SKIP_FC1
        { const Ctx C = CTX(l); pg8::Gemm g{C.H, wts(C.p, l, W_FC1), nrows, DFF, D, D, 1 << 30, 0}; pg8::StaticOrder S; S.init(nrows, DFF, ogrid(), obid()); EpiRelu2 E{C.HID()}; pg8::gemm_phase<EpiRelu2, true>(ring, g, S, E, TID); }
#endif
        SEAM();
#ifndef SKIP_FC2
        { const Ctx C = CTX(l); pg8::Gemm g{C.HID(), wts(C.p, l, W_FC2), nrows, D, DFF, DFF, 1 << 30, 0}; pg8::StaticOrder S; S.init(nrows, D, ogrid(), obid()); EpiRes E{C, 5, false}; pg8::gemm_phase<EpiRes, true>(ring, g, S, E, TID); }
#endif
        SEAM();
        { const Ctx C = CTX(l); ph_ln(C, nrows, C.p.ln2_g + l * D, C.p.ln2_b + l * D, !last, l + 1, 0, nullptr); }
        if (!last) SEAM();
    }
    { const Ctx C = CTX(0); if (xb_ld((unsigned*)(C.p.ws + WS_CTL) + CW_BAR + XB_TMO) != 0u) { __syncthreads(); for (int i = GTID; i < ML * D; i += gsz) C.p.out[i] = __builtin_nanf(""); } }
#undef TID
#undef GTID
#undef CTX
#undef SEAM
}

extern "C" void kernel_launch(void* const* d_in, const int* in_sizes, int n_in, void* d_out, int out_size, void* d_ws, size_t ws_size, hipStream_t stream) {
    static int grid = 0;
    if (grid == 0) {
        if (n_in != 22 || out_size != ML * D || ws_size < WS_END) { fprintf(stderr, "kernel_launch: unexpected shapes n_in %d out %d ws %zu (need %zu)\n", n_in, out_size, ws_size, (size_t)WS_END); grid = -1; return; }
        int dev = 0, cus = 0, per_cu = 0;
        hipGetDevice(&dev); hipDeviceGetAttribute(&cus, hipDeviceAttributeMultiprocessorCount, dev);
        hipFuncSetAttribute((const void*)fwd_kernel, hipFuncAttributeMaxDynamicSharedMemorySize, LDS_BYTES);
        hipOccupancyMaxActiveBlocksPerMultiprocessor(&per_cu, (const void*)fwd_kernel, NTHREADS, LDS_BYTES);
        if (per_cu < 1) { fprintf(stderr, "kernel_launch: occupancy query says %d blocks per CU\n", per_cu); grid = -1; return; }
        grid = cus;
    }
    if (grid < 0) return;
    hipMemsetAsync((char*)d_ws + WS_CTL, 0, 1 * MiB, stream);
    Params p{};
    const float** pp = (const float**)&p;
    for (int i = 0; i < 22; ++i) pp[i] = (const float*)d_in[i];
    p.out = (float*)d_out; p.ws = (unsigned char*)d_ws;
    void* args[] = {&p};
    hipError_t e = hipLaunchCooperativeKernel((const void*)fwd_kernel, dim3(grid), dim3(NTHREADS), args, LDS_BYTES, stream);
    if (e != hipSuccess) fprintf(stderr, "cooperative launch failed: %s (grid %d)\n", hipGetErrorString(e), grid);
}
```

```cpp
#include <hip/hip_runtime.h>
#include <hip/hip_cooperative_groups.h>
#include <cstdio>
#include <cstdint>
namespace cg = cooperative_groups;

constexpr int D = 1024, NB = 2, SEQ = 8192, CTX = 256, DEPTH = 2;
constexpr int ML = NB * SEQ, MC = NB * CTX, MA = ML + MC;
constexpr int DIN = 1440, DFF = 4096, DMOD = 6 * D;
constexpr int KROWS = CTX + SEQ, NTILE = KROWS / 64;
constexpr float LN_EPS = 1e-6f, RMS_EPS = 1e-6f;
constexpr float ALPHA = 1.41421356237309515f;
constexpr float LOG2E = 1.4426950408889634f;
constexpr float C2AB = 0.125f * LOG2E;
constexpr float C2C = 0.10206207261596577f * LOG2E;
constexpr int NTHREADS = 512;

typedef unsigned short bf16;

constexpr size_t MiB = 1u << 20;
constexpr size_t al(size_t x) { return (x + 255) & ~(size_t)255; }
constexpr size_t WS_CTL = 0;
constexpr size_t WS_MOD = 1 * MiB;
constexpr size_t WS_T64 = WS_MOD + al((size_t)DEPTH * 3 * DMOD * 4);
constexpr size_t WS_T32 = WS_T64 + al(128 * 16 * 8);
constexpr size_t WS_SSQ = WS_T32 + al(128 * 8 * 8);
constexpr size_t WS_RC = WS_SSQ + al((size_t)MA * 8 * 4);
constexpr size_t WS_H = WS_RC + al((size_t)MC * D * 4);
constexpr size_t WS_W = WS_H + al((size_t)MA * D * 2);
constexpr size_t W_IN = 0, W_UP = W_IN + (size_t)1536 * 1024 * 2, W_OUT = W_UP + (size_t)1792 * 256 * 2,
                 W_FC1 = W_OUT + (size_t)1024 * 1024 * 2, W_FC2 = W_FC1 + (size_t)4096 * 1024 * 2, W_LAYER = W_FC2 + (size_t)4096 * 1024 * 2;
constexpr size_t WS_R = WS_W + al(DEPTH * W_LAYER);
constexpr size_t R_QA = 0, R_QB = R_QA + (size_t)MA * 256 * 2, R_QC = R_QB + (size_t)MA * 256 * 2, R_AUP = R_QC + (size_t)MA * 768 * 2,
                 R_KA = R_AUP + (size_t)MA * 512 * 2, IMG64 = (size_t)NTILE * 4096 * 2  ,
                 R_VA = R_KA + 4 * IMG64, R_KB = R_VA + 4 * IMG64, R_VB = R_KB + 4 * IMG64, R_KC = R_VB + 4 * IMG64, R_VC = R_KC + 16 * IMG64,
                 R_KR = R_VC + 16 * IMG64, R_Y = R_KR + 2 * IMG64 / 2, R_END = R_Y + (size_t)MA * D * 2;
constexpr size_t R_HID = 0;
static_assert((size_t)MA * DFF * 2 <= R_END, "hid overlay");
constexpr size_t WS_END = WS_R + R_END;
static_assert(WS_END <= 256 * MiB, "workspace");

struct Params {
    const float *x, *c, *ctx, *c_ctx, *w_mod, *b_mod, *w_in, *sink_a, *q_norm_b, *k_norm_b, *mla_q_norm, *mla_kv_norm,
        *w_uq, *w_uk, *w_uv, *w_out, *ln1_g, *ln1_b, *w_fc1, *w_fc2, *ln2_g, *ln2_b;
    float* out; unsigned char* ws;
};

__device__ __forceinline__ unsigned f2bf(float f) { unsigned u = __builtin_bit_cast(unsigned, f); return (u + 0x7fffu + ((u >> 16) & 1u)) >> 16; }
__device__ __forceinline__ int otid(int wave) {
    int l; asm volatile("v_mbcnt_lo_u32_b32 %0, -1, 0\n\tv_mbcnt_hi_u32_b32 %0, -1, %0" : "=v"(l)); return wave * 64 + l; }
__device__ __forceinline__ int obid() { int b = blockIdx.x; asm volatile("" : "+s"(b)); return b; }
__device__ __forceinline__ int ogrid() { int g = gridDim.x; asm volatile("" : "+s"(g)); return g; }
__device__ __forceinline__ float bf2f(unsigned h) { return __builtin_bit_cast(float, h << 16); }
__device__ __forceinline__ void swap32(float v, float& lo, float& hi) {
    float a = v, b;
    asm volatile("v_mov_b32_e32 %1, %0\n\ts_nop 1\n\tv_permlane32_swap_b32_e32 %0, %1" : "+v"(a), "=&v"(b));
    lo = a; hi = b;
}
__device__ __forceinline__ float wave_sum(float v) {
#define WS_STEP(m) v += __builtin_bit_cast(float, __builtin_amdgcn_ds_swizzle(__builtin_bit_cast(int, v), (m)))
    WS_STEP(0x041f); WS_STEP(0x081f); WS_STEP(0x101f); WS_STEP(0x201f); WS_STEP(0x401f);
#undef WS_STEP
    float lo, hi; swap32(v, lo, hi); return lo + hi;
}
__device__ __forceinline__ size_t kimg(int krow, int d) { return ((size_t)((krow >> 6) * 8 + (d >> 3)) * 64 + (krow & 63)) * 8 + (d & 7); }
__device__ __forceinline__ size_t krimg(int krow, int d) { return ((size_t)((krow >> 6) * 4 + (d >> 3)) * 64 + (krow & 63)) * 8 + (d & 7); }
__device__ __forceinline__ size_t vimg(int krow, int d) { const int rr = krow & 63; return (size_t)(krow >> 6) * 4096 + (d >> 5) * 2048 + (rr >> 4) * 512 + (rr & 15) * 32 + (d & 31); }
struct RowInfo { int b, krow, set, t; bool lat; };
__device__ __forceinline__ RowInfo row_info(int r) {
    RowInfo ri;
    if (r < ML) { ri.b = r >> 13; ri.t = r & (SEQ - 1); ri.krow = CTX + ri.t; ri.set = ri.b; ri.lat = true; }
    else { const int j = r - ML; ri.b = j >> 8; ri.t = 0; ri.krow = j & 255; ri.set = 2; ri.lat = false; }
    return ri;
}
struct Ctx {
    Params p; int layer, wave;
    __device__ __forceinline__ int tid() const { return otid(wave); }
    float* MOD; float2* T64; float2* T32; float* SSQ; float* RC; bf16* H; unsigned char* R;
    __device__ __forceinline__ const float* mod(int set, int which) const { return MOD + ((size_t)(layer * 3 + set) * 6 + which) * D; }
    __device__ __forceinline__ const float* resid_in(int r) const {
        if (layer == 0) return r < ML ? p.x + (size_t)r * D : p.ctx + (size_t)(r - ML) * D;
        return r < ML ? p.out + (size_t)r * D : RC + (size_t)(r - ML) * D; }
    __device__ __forceinline__ float* resid(int r) const { return r < ML ? p.out + (size_t)r * D : RC + (size_t)(r - ML) * D; }
    __device__ __forceinline__ bf16* QA() const { return (bf16*)(R + R_QA); }
    __device__ __forceinline__ bf16* QB() const { return (bf16*)(R + R_QB); }
    __device__ __forceinline__ bf16* QC() const { return (bf16*)(R + R_QC); }
    __device__ __forceinline__ bf16* AUP() const { return (bf16*)(R + R_AUP); }
    __device__ __forceinline__ bf16* KA(int b, int kv) const { return (bf16*)(R + R_KA + (size_t)(b * 2 + kv) * IMG64); }
    __device__ __forceinline__ bf16* VA(int b, int kv) const { return (bf16*)(R + R_VA + (size_t)(b * 2 + kv) * IMG64); }
    __device__ __forceinline__ bf16* KB(int b, int kv) const { return (bf16*)(R + R_KB + (size_t)(b * 2 + kv) * IMG64); }
    __device__ __forceinline__ bf16* VB(int b, int kv) const { return (bf16*)(R + R_VB + (size_t)(b * 2 + kv) * IMG64); }
    __device__ __forceinline__ bf16* KC(int b, int h) const { return (bf16*)(R + R_KC + (size_t)(b * 8 + h) * IMG64); }
    __device__ __forceinline__ bf16* VC(int b, int h) const { return (bf16*)(R + R_VC + (size_t)(b * 8 + h) * IMG64); }
    __device__ __forceinline__ bf16* KR(int b) const { return (bf16*)(R + R_KR + (size_t)b * (IMG64 / 2)); }
    __device__ __forceinline__ bf16* Y() const { return (bf16*)(R + R_Y); }
    __device__ __forceinline__ bf16* HID() const { return (bf16*)(R + R_HID); }
};

namespace nv {
__device__ __forceinline__ float silu(float v) { return v / (1.f + expf(-v)); }

__device__ __forceinline__ void ph_mod_tables(const Ctx& C, int gtid, int gsz) {
    for (int idx = gtid; idx < DEPTH * 3 * DMOD; idx += gsz) {
        const int l = idx / (3 * DMOD), s = (idx / DMOD) % 3, n = idx % DMOD;
        const float* cv = s < 2 ? C.p.c + s * D : C.p.c_ctx;
        const float* w = C.p.w_mod + (size_t)l * D * DMOD + n;
        float acc = C.p.b_mod[l * DMOD + n];
        for (int k = 0; k < D; ++k) acc += silu(cv[k]) * w[(size_t)k * DMOD];
        C.MOD[idx] = acc;
    }
    for (int idx = gtid; idx < 128 * 16; idx += gsz) { const int pos = idx >> 4, j = idx & 15; const float inv = powf(10000.f, -(float)j / 16.f), a = (float)pos * inv; C.T64[idx] = make_float2(cosf(a), sinf(a)); }
    for (int idx = gtid; idx < 128 * 8; idx += gsz) { const int pos = idx >> 3, j = idx & 7; const float inv = powf(10000.f, -(float)j / 8.f), a = (float)pos * inv; C.T32[idx] = make_float2(cosf(a), sinf(a)); }
}
__device__ __forceinline__ void ph_modulate(const Ctx& C, int gtid, int gsz, int nrows) {
    for (size_t idx = gtid; idx < (size_t)nrows * (D / 4); idx += gsz) {
        const int r = (int)(idx / (D / 4)), c4 = (int)(idx % (D / 4)) * 4; const RowInfo ri = row_info(r);
        const float4 v = *(const float4*)(C.resid_in(r) + c4); const float4 sc = *(const float4*)(C.mod(ri.set, 1) + c4), sh = *(const float4*)(C.mod(ri.set, 0) + c4);
        ushort4 o; o.x = f2bf(v.x * (1.f + sc.x) + sh.x); o.y = f2bf(v.y * (1.f + sc.y) + sh.y); o.z = f2bf(v.z * (1.f + sc.z) + sh.z); o.w = f2bf(v.w * (1.f + sc.w) + sh.w);
        *(ushort4*)(C.H + (size_t)r * D + c4) = o;
    }
}
__device__ __forceinline__ void rope64(float* v, int t, const float2* T64) {
#pragma unroll
    for (int i = 0; i < 32; ++i) { const int pos = i < 16 ? (t >> 6) : (t & 63); const float2 cs = T64[pos * 16 + (i & 15)]; const float x1 = v[i], x2 = v[i + 32]; v[i] = x1 * cs.x - x2 * cs.y; v[i + 32] = x1 * cs.y + x2 * cs.x; }
}
__device__ __forceinline__ void rope32(float* v, int t, const float2* T32) {
#pragma unroll
    for (int i = 0; i < 16; ++i) { const int pos = i < 8 ? (t >> 6) : (t & 63); const float2 cs = T32[pos * 8 + (i & 7)]; const float x1 = v[i], x2 = v[i + 16]; v[i] = x1 * cs.x - x2 * cs.y; v[i + 16] = x1 * cs.y + x2 * cs.x; }
}
template <int NJ> __device__ __forceinline__ void dotrow(float* acc, const bf16* a, const float* w, int K, int ldw, const float* kscale) {
    for (int k = 0; k < K; ++k) { float av = bf2f(a[k]); if (kscale) av *= kscale[k]; const float* wr = w + (size_t)k * ldw;
#pragma unroll
        for (int j = 0; j < NJ; ++j) acc[j] += av * wr[j]; }
}
__device__ __forceinline__ void ph_in(const Ctx& C, int gtid, int gsz) {
    const int l = C.layer; const float* W = C.p.w_in + (size_t)l * D * DIN;
    for (int task = gtid; task < 23 * MA; task += gsz) {
        const int slot = __builtin_amdgcn_readfirstlane(task / MA), r = task % MA; const RowInfo ri = row_info(r);
        float acc[64];
#pragma unroll
        for (int j = 0; j < 64; ++j) acc[j] = 0.f;
        const bf16* a = C.H + (size_t)r * D;
        if (slot < 22) dotrow<64>(acc, a, W + slot * 64, D, DIN, nullptr); else dotrow<32>(acc, a, W + 1408, D, DIN, nullptr);
        if (slot < 16) {
            const int grp = slot >> 2 & 1 ? 1 : 0;
            const bool isB = slot >= 8; const int s8 = slot & 7;
            const bool isq = s8 < 4, isk = s8 == 4 || s8 == 5; (void)grp;
            if (isB && (isq || isk)) { float ss = 0.f;
#pragma unroll
                for (int j = 0; j < 64; ++j) ss += acc[j] * acc[j];
                const float rs = rsqrtf(ss * (1.f / 64.f) + RMS_EPS); const float* g = (isq ? C.p.q_norm_b : C.p.k_norm_b) + l * 64;
#pragma unroll
                for (int j = 0; j < 64; ++j) acc[j] = acc[j] * rs * g[j]; }
            if ((isq || isk) && ri.lat) rope64(acc, ri.t, C.T64);
            if (isq) { bf16* q = (isB ? C.QB() : C.QA()) + (size_t)r * 256 + s8 * 64;
#pragma unroll
                for (int j = 0; j < 64; ++j) q[j] = f2bf(acc[j] * C2AB); }
            else if (isk) { bf16* k = isB ? C.KB(ri.b, s8 - 4) : C.KA(ri.b, s8 - 4);
#pragma unroll
                for (int j = 0; j < 64; ++j) k[kimg(ri.krow, j)] = f2bf(acc[j]); }
            else { bf16* v = isB ? C.VB(ri.b, s8 - 6) : C.VA(ri.b, s8 - 6);
#pragma unroll
                for (int j = 0; j < 64; ++j) v[vimg(ri.krow, j)] = f2bf(acc[j]); }
        } else if (slot < 22) {
            const int p = slot - 16; float ss = 0.f; bf16* o = C.AUP() + (size_t)r * 512 + p * 64;
#pragma unroll
            for (int j = 0; j < 64; ++j) { ss += acc[j] * acc[j]; o[j] = f2bf(acc[j]); }
            C.SSQ[(size_t)r * 8 + p] = ss;
            if (p >= 4) { C.SSQ[(size_t)r * 8 + p + 2] = 0.f;
#pragma unroll
                for (int j = 0; j < 64; ++j) o[128 + j] = 0; }
        } else {
            if (ri.lat) rope32(acc, ri.t, C.T32);
            bf16* k = C.KR(ri.b);
#pragma unroll
            for (int j = 0; j < 32; ++j) k[krimg(ri.krow, j)] = f2bf(acc[j]);
        }
    }
}
__device__ __forceinline__ void ph_up(const Ctx& C, int gtid, int gsz) {
    const int l = C.layer;
    for (int task = gtid; task < 24 * MA; task += gsz) {
        const int g = __builtin_amdgcn_readfirstlane(task / MA), r = task % MA; const RowInfo ri = row_info(r);
        const float* sq = C.SSQ + (size_t)r * 8;
        float acc[96];
#pragma unroll
        for (int j = 0; j < 96; ++j) acc[j] = 0.f;
        if (g < 8) {
            const float rs = rsqrtf((sq[0] + sq[1] + sq[2] + sq[3]) * (1.f / 256.f) + RMS_EPS);
            dotrow<96>(acc, C.AUP() + (size_t)r * 512, C.p.w_uq + (size_t)l * 256 * 768 + g * 96, 256, 768, C.p.mla_q_norm + l * 256);
#pragma unroll
            for (int j = 0; j < 96; ++j) acc[j] *= rs;
            if (ri.lat) rope32(acc + 64, ri.t, C.T32);
            bf16* q = C.QC() + (size_t)r * 768 + g * 96;
#pragma unroll
            for (int j = 0; j < 96; ++j) q[j] = f2bf(acc[j] * C2C);
        } else {
            const float rs = rsqrtf((sq[4] + sq[5] + sq[6] + sq[7]) * (1.f / 128.f) + RMS_EPS); const int h = g & 7; const bool isk = g < 16;
            dotrow<64>(acc, C.AUP() + (size_t)r * 512 + 256, (isk ? C.p.w_uk : C.p.w_uv) + (size_t)l * 128 * 512 + h * 64, 128, 512, C.p.mla_kv_norm + l * 128);
            bf16* o = isk ? C.KC(ri.b, h) : C.VC(ri.b, h);
#pragma unroll
            for (int j = 0; j < 64; ++j) o[isk ? kimg(ri.krow, j) : vimg(ri.krow, j)] = f2bf(acc[j] * rs);
        }
    }
}
template <int DQK> __device__ __forceinline__ void attn_unit(const Ctx& C, float* lds, int type  , int b, int h, int row0, int nq, bool lat) {
    float* Ks = lds; float* Vs = lds + 64 * DQK;
    const int tid = C.tid(); const bool act = tid < nq; const int r = row0 + (act ? tid : 0);
    const int kvh = type == 2 ? h : (h >> 1);
    const bf16* Kimg = type == 0 ? C.KA(b, kvh) : type == 1 ? C.KB(b, kvh) : C.KC(b, kvh);
    const bf16* Vimg = type == 0 ? C.VA(b, kvh) : type == 1 ? C.VB(b, kvh) : C.VC(b, kvh);
    const bf16* Q = type == 0 ? C.QA() + (size_t)r * 256 + h * 64 : type == 1 ? C.QB() + (size_t)r * 256 + h * 64 : C.QC() + (size_t)r * 768 + h * 96;
    float q[DQK], o[64];
#pragma unroll
    for (int j = 0; j < DQK; ++j) q[j] = bf2f(Q[j]);
#pragma unroll
    for (int j = 0; j < 64; ++j) o[j] = 0.f;
    float m = -1e30f, lsum = 0.f;
    const int qpos = lat ? (r & (SEQ - 1)) : 0;
    int tlo = 4, thi = lat ? NTILE : 4;
    if (type == 0 && lat) { const int p0 = (row0 & (SEQ - 1)); int lo = p0 - 128, hi = p0 + nq + 128; if (lo < 0) lo = 0; if (hi > SEQ) hi = SEQ; tlo = 4 + lo / 64; thi = 4 + hi / 64; }
    for (int pass = 0; pass < 2; ++pass) {
        const int ta = pass == 0 ? 0 : tlo, tb = pass == 0 ? 4 : thi;
        for (int t = ta; t < tb; ++t) {
            __syncthreads();
            for (int e = tid; e < 64 * DQK; e += NTHREADS) { const int key = e / DQK, d = e % DQK;
                Ks[e] = d < 64 ? bf2f(Kimg[kimg(t * 64 + key, d)]) : bf2f(C.KR(b)[krimg(t * 64 + key, d - 64)]); }
            for (int e = tid; e < 64 * 64; e += NTHREADS) { const int key = e >> 6, d = e & 63; Vs[e] = bf2f(Vimg[vimg(t * 64 + key, d)]); }
            __syncthreads();
            for (int key = 0; key < 64; ++key) {
                float s = 0.f;
#pragma unroll
                for (int j = 0; j < DQK; ++j) s += q[j] * Ks[key * DQK + j];
                if (type == 0 && t >= 4) { const int kpos = (t - 4) * 64 + key; const int rel = kpos - qpos; if (rel > 128 || rel < -128) s = -1e30f; }
                if (s > m) { const float f = exp2f(m - s); lsum *= f;
#pragma unroll
                    for (int j = 0; j < 64; ++j) o[j] *= f;
                    m = s; }
                const float pr = exp2f(s - m); lsum += pr;
#pragma unroll
                for (int j = 0; j < 64; ++j) o[j] += pr * Vs[key * 64 + j];
            }
        }
    }
    if (type == 0) lsum += exp2f(C.p.sink_a[C.layer * 4 + h] * LOG2E - m);
    if (act) { const float inv = 1.f / lsum; bf16* y = C.Y() + (size_t)r * D + (type == 0 ? 0 : type == 1 ? 256 : 512) + h * 64;
#pragma unroll
        for (int j = 0; j < 64; ++j) y[j] = f2bf(o[j] * inv); }
}
__device__ __forceinline__ void ph_attn(const Ctx& C, float* lds, bool with_ctx) {
    const int nlat = 128 + 128 + 256, nctx = with_ctx ? 32 : 0;
    for (int u = obid(); u < nlat + nctx; u += ogrid()) {
        if (u < nlat) {
            int type, idx; if (u < 128) { type = 0; idx = u; } else if (u < 256) { type = 1; idx = u - 128; } else { type = 2; idx = u - 256; }
            const int nh = type == 2 ? 8 : 4; const int qb = idx & 15, h = (idx >> 4) % nh, b = (idx >> 4) / nh;
            if (type == 2) attn_unit<96>(C, lds, type, b, h, b * SEQ + qb * 512, 512, true); else attn_unit<64>(C, lds, type, b, h, b * SEQ + qb * 512, 512, true);
        } else {
            const int v = u - nlat; int type, idx; if (v < 8) { type = 0; idx = v; } else if (v < 16) { type = 1; idx = v - 8; } else { type = 2; idx = v - 16; }
            const int nh = type == 2 ? 8 : 4; const int h = idx % nh, b = idx / nh;
            if (type == 2) attn_unit<96>(C, lds, type, b, h, ML + b * CTX, 256, false); else attn_unit<64>(C, lds, type, b, h, ML + b * CTX, 256, false);
        }
    }
}
__device__ __forceinline__ void ph_proj_res(const Ctx& C, int gtid, int gsz, const bf16* A, int K, const float* W  , int which_gate, int nrows, bool first) {
    for (int task = gtid; task < 16 * nrows; task += gsz) {
        const int cgp = __builtin_amdgcn_readfirstlane(task / nrows), r = task % nrows; const RowInfo ri = row_info(r);
        float acc[64];
#pragma unroll
        for (int j = 0; j < 64; ++j) acc[j] = 0.f;
        dotrow<64>(acc, A + (size_t)r * K, W + cgp * 64, K, D, nullptr);
        const float* base = first ? C.resid_in(r) : C.resid(r); float* o = C.resid(r); const float* g = C.mod(ri.set, which_gate);
#pragma unroll
        for (int j = 0; j < 64; ++j) { const int c = cgp * 64 + j; o[c] = ALPHA * base[c] + g[c] * acc[j]; }
    }
}
__device__ __forceinline__ void ph_fc1(const Ctx& C, int gtid, int gsz, int nrows) {
    const float* W = C.p.w_fc1 + (size_t)C.layer * D * DFF;
    for (int task = gtid; task < 64 * nrows; task += gsz) {
        const int cgp = __builtin_amdgcn_readfirstlane(task / nrows), r = task % nrows;
        float acc[64];
#pragma unroll
        for (int j = 0; j < 64; ++j) acc[j] = 0.f;
        dotrow<64>(acc, C.H + (size_t)r * D, W + cgp * 64, D, DFF, nullptr);
        bf16* o = C.HID() + (size_t)r * DFF + cgp * 64;
#pragma unroll
        for (int j = 0; j < 64; ++j) { const float a = fmaxf(acc[j], 0.f); o[j] = f2bf(a * a); }
    }
}
}

__device__ __forceinline__ void ph_ln(const Ctx& C, int nrows, const float* g, const float* bta, bool make_h, int mlayer, int which_sh, float* final_out_unused) {
    const int tid_ = C.tid(); const int lane = tid_ & 63, gw = obid() * (NTHREADS / 64) + (tid_ >> 6), ngw = ogrid() * (NTHREADS / 64);
    for (int r = gw; r < nrows; r += ngw) {
        float* xr = C.resid(r); const RowInfo ri = row_info(r);
        float4 v[4]; float s = 0.f;
#pragma unroll
        for (int j = 0; j < 4; ++j) { v[j] = *(const float4*)(xr + 4 * lane + 256 * j); s += (v[j].x + v[j].y) + (v[j].z + v[j].w); }
        const float mean = wave_sum(s) * (1.f / D); float s2 = 0.f;
#pragma unroll
        for (int j = 0; j < 4; ++j) { v[j].x -= mean; v[j].y -= mean; v[j].z -= mean; v[j].w -= mean; s2 += (v[j].x * v[j].x + v[j].y * v[j].y) + (v[j].z * v[j].z + v[j].w * v[j].w); }
        const float rstd = rsqrtf(wave_sum(s2) * (1.f / D) + LN_EPS);
        const float* sc = C.MOD + ((size_t)(mlayer * 3 + ri.set) * 6 + which_sh + 1) * D; const float* sh = C.MOD + ((size_t)(mlayer * 3 + ri.set) * 6 + which_sh) * D;
#pragma unroll
        for (int j = 0; j < 4; ++j) { const int c = 4 * lane + 256 * j; const float4 gg = *(const float4*)(g + c), bb = *(const float4*)(bta + c);
            float4 y; y.x = v[j].x * rstd * gg.x + bb.x; y.y = v[j].y * rstd * gg.y + bb.y; y.z = v[j].z * rstd * gg.z + bb.z; y.w = v[j].w * rstd * gg.w + bb.w;
            *(float4*)(xr + c) = y;
            if (make_h) { const float4 a = *(const float4*)(sc + c), d = *(const float4*)(sh + c); ushort4 o;
                o.x = f2bf(y.x * (1.f + a.x) + d.x); o.y = f2bf(y.y * (1.f + a.y) + d.y); o.z = f2bf(y.z * (1.f + a.z) + d.z); o.w = f2bf(y.w * (1.f + a.w) + d.w);
                *(ushort4*)(C.H + (size_t)r * D + c) = o; } }
    }
}


namespace pg8 {
#define PG8_LAS __attribute__((address_space(3)))
typedef PG8_LAS unsigned char* PG8_LAS_T;
typedef unsigned short bf16_t;
typedef short bf16x8 __attribute__((ext_vector_type(8)));
typedef float f32x4 __attribute__((ext_vector_type(4)));
typedef unsigned u32x4 __attribute__((ext_vector_type(4)));
typedef unsigned u32x2 __attribute__((ext_vector_type(2)));
constexpr int BM = 256, BK = 64, HALF = 128, HTB = HALF * BK * 2, STAGE_BYTES = 8 * HTB, NXCD = 8, WGM = 8;
__host__ __device__ __forceinline__ int lds_byte(int r, int c) { const int st = (r >> 4) * 2 + (c >> 5), rr = r & 15, cc = c & 31, ob = rr * 64 + cc * 2; return st * 1024 + (ob ^ (((ob >> 9) & 1) << 5)); }
__host__ __device__ __forceinline__ void stage_rc(int b, int& R, int& C) { const int st = b / 1024, sb = b % 1024, swz = sb ^ (((sb >> 9) & 1) << 5); R = (st >> 1) * 16 + swz / 64; C = (st & 1) * 32 + (swz % 64) / 2; }
__host__ __device__ __forceinline__ int perm32(int rho) { const int n = rho >> 4, i = rho & 15; return 8 * (i >> 2) + 4 * n + (i & 3); }
struct Unit { int pm, pn; };
struct Gemm { const bf16_t* A; const bf16_t* Bt; int M, N, K, lda, asplit, akoff; };
struct StaticOrder {
    int nM, nN, nwg, G, c;
    __host__ __device__ void init(int M, int N, int G_, int c_) { nM = M / BM; nN = N / BM; nwg = nM * nN; G = G_; c = c_; }
    __host__ __device__ bool next(int i, Unit& u) const {
        const long L = (long)i * G + c; if (L >= nwg) return false;
        int wgid = (int)L; { const int q = nwg / NXCD, r = nwg % NXCD, xcd = wgid % NXCD, off = wgid / NXCD; wgid = (xcd < r ? xcd * (q + 1) : r * (q + 1) + (xcd - r) * q) + off; }
        const int nig = WGM * nN, gid = wgid / nig, fm = gid * WGM, gsz = (nM - fm) < WGM ? (nM - fm) : WGM;
        u.pm = fm + ((wgid % nig) % gsz); u.pn = (wgid % nig) / gsz; return true;
    }
};
__device__ __forceinline__ unsigned cvt_pk_bf16(float lo, float hi) { unsigned r; asm volatile("v_cvt_pk_bf16_f32 %0, %1, %2" : "=v"(r) : "v"(lo), "v"(hi)); return r; }
__device__ __forceinline__ u32x4 pack8(const f32x4& a, const f32x4& b) { u32x4 w; w.x = cvt_pk_bf16(a[0], a[1]); w.y = cvt_pk_bf16(a[2], a[3]); w.z = cvt_pk_bf16(b[0], b[1]); w.w = cvt_pk_bf16(b[2], b[3]); return w; }

template <class Epi, bool ALIGN_EPI>
__device__ __forceinline__ void gemm_phase(PG8_LAS unsigned char* lds, const Gemm g, const StaticOrder& S, const Epi& E, const int tid) {
    const int wid = __builtin_amdgcn_readfirstlane(tid >> 6), lane = tid & 63, wr = wid >> 2, wc = wid & 3, fr = lane & 15, fq = lane >> 4;
    const int K = g.K, nt = K / BK, lda = g.lda;
    unsigned voffA[2], voffB[2];
#pragma unroll
    for (int i = 0; i < 2; ++i) { int R, C; stage_rc(tid * 16 + i * 8192, R, C); const int Rb = Epi::PERM ? ((R & ~31) + perm32(R & 31)) : R;
        voffA[i] = (unsigned)(R * lda + C) * 2u; voffB[i] = (unsigned)(Rb * K + C) * 2u; }
    const size_t kstep = (size_t)(BK * 2);
    const size_t hstepA = (size_t)HALF * lda * 2, tstepA = 2 * hstepA;
    const size_t hstepB = (size_t)HALF * K * 2, tstepB = 2 * hstepB;
    const unsigned ldsw = (unsigned)wid * 1024u;
    const int aoff = lds_byte(wr * 64 + fr, fq * 8), boff = lds_byte(wc * 32 + fr, fq * 8);
#define PG8_SA(b, h) (((b) * 2 + (h)) * HTB)
#define PG8_SB(b, h) ((4 + (b) * 2 + (h)) * HTB)
#define PG8_STAGE(bufoff, gbase, voff) do { _Pragma("unroll") for (int _i = 0; _i < 2; ++_i) \
        __builtin_amdgcn_global_load_lds((const unsigned*)((const char*)(gbase) + (voff)[_i]), (PG8_LAS unsigned*)(lds + (bufoff) + ldsw + _i * 8192), 16, 0, 0); } while (0)
#define PG8_LDA(dst, b, h) do { _Pragma("unroll") for (int m = 0; m < 4; ++m) _Pragma("unroll") for (int k = 0; k < 2; ++k) dst[m][k] = *(const PG8_LAS bf16x8*)(lds + PG8_SA(b, h) + aoff + m * 2048 + k * 1024); } while (0)
#define PG8_LDB(dst, b, h) do { _Pragma("unroll") for (int n = 0; n < 2; ++n) _Pragma("unroll") for (int k = 0; k < 2; ++k) dst[n][k] = *(const PG8_LAS bf16x8*)(lds + PG8_SB(b, h) + boff + n * 2048 + k * 1024); } while (0)
#define PG8_MMA(ai, bj, At, Bt) do { __builtin_amdgcn_s_setprio(1); _Pragma("unroll") for (int m = 0; m < 4; ++m) _Pragma("unroll") for (int n = 0; n < 2; ++n) _Pragma("unroll") for (int k = 0; k < 2; ++k) \
        acc[ai][bj][m][n] = __builtin_amdgcn_mfma_f32_16x16x32_bf16(Bt[n][k], At[m][k], acc[ai][bj][m][n], 0, 0, 0); __builtin_amdgcn_s_setprio(0); } while (0)
#define PG8_WAIT_V(n) asm volatile("s_waitcnt vmcnt(" #n ")" ::: "memory")
#define PG8_WAIT_L(n) asm volatile("s_waitcnt lgkmcnt(" #n ")" ::: "memory")
#define PG8_BAR __builtin_amdgcn_s_barrier()
#define PG8_SCHED __builtin_amdgcn_sched_barrier(0)
#define PG8_APTR(u) ((const char*)g.A + (size_t)(u).pm * tstepA + ((u).pn >= g.asplit ? (size_t)g.akoff * 2 : (size_t)0))
    Unit cur, nxt; int ui = 0;
    if (!S.next(0, cur)) return;
    f32x4 acc[2][2][4][2];
#pragma unroll
    for (int a = 0; a < 2; ++a)
#pragma unroll
        for (int b = 0; b < 2; ++b)
#pragma unroll
            for (int m = 0; m < 4; ++m)
#pragma unroll
                for (int n = 0; n < 2; ++n) acc[a][b][m][n] = (f32x4){0.f, 0.f, 0.f, 0.f};
    bf16x8 At[4][2], B0[2][2], B1[2][2];
    const char* cA = PG8_APTR(cur); const char* cB = (const char*)g.Bt + (size_t)cur.pn * tstepB;
    {
        PG8_STAGE(PG8_SB(0, 0), cB, voffB); PG8_STAGE(PG8_SB(0, 1), cB + hstepB, voffB); PG8_STAGE(PG8_SA(0, 0), cA, voffA); PG8_STAGE(PG8_SA(0, 1), cA + hstepA, voffA);
        if (wr == 1) PG8_BAR;
        PG8_WAIT_V(2); PG8_BAR;
        PG8_STAGE(PG8_SB(1, 0), cB + kstep, voffB); PG8_STAGE(PG8_SA(1, 0), cA + kstep, voffA); PG8_STAGE(PG8_SB(1, 1), cB + hstepB + kstep, voffB);
        PG8_WAIT_V(6); PG8_BAR;
    }
    for (;;) {
        const bool has_next = S.next(ui + 1, nxt);
        const char* nA = has_next ? PG8_APTR(nxt) : cA; const char* nB = has_next ? (const char*)g.Bt + (size_t)nxt.pn * tstepB : cB;
        for (int t = 0; t < nt; t += 2) {
            const bool last = (t == nt - 2);
            const char* a1 = cA + (size_t)(t + 1) * kstep;
            const char* a2 = last ? nA : cA + (size_t)(t + 2) * kstep; const char* b2 = last ? nB : cB + (size_t)(t + 2) * kstep;
            const char* a3 = a2 + kstep; const char* b3 = b2 + kstep;
            PG8_LDB(B0, 0, 0); PG8_LDB(B1, 0, 1); PG8_SCHED; PG8_LDA(At, 0, 0); PG8_STAGE(PG8_SA(1, 1), a1 + hstepA, voffA);
            PG8_WAIT_V(8); PG8_WAIT_L(0); PG8_BAR; PG8_MMA(0, 0, At, B0); PG8_MMA(0, 1, At, B1); PG8_BAR; PG8_SCHED;
            PG8_LDA(At, 0, 1); PG8_STAGE(PG8_SB(0, 0), b2, voffB); PG8_STAGE(PG8_SB(0, 1), b2 + hstepB, voffB); PG8_STAGE(PG8_SA(0, 0), a2, voffA);
            PG8_WAIT_V(8); PG8_WAIT_L(0); PG8_BAR; PG8_MMA(1, 0, At, B0); PG8_MMA(1, 1, At, B1); PG8_BAR; PG8_SCHED;
            PG8_LDB(B0, 1, 0); PG8_LDB(B1, 1, 1); PG8_SCHED; PG8_LDA(At, 1, 0); PG8_STAGE(PG8_SA(0, 1), a2 + hstepA, voffA);
            PG8_WAIT_V(8); PG8_WAIT_L(0); PG8_BAR; PG8_MMA(0, 0, At, B0); PG8_MMA(0, 1, At, B1); PG8_BAR; PG8_SCHED;
            PG8_LDA(At, 1, 1); PG8_STAGE(PG8_SB(1, 0), b3, voffB); PG8_STAGE(PG8_SB(1, 1), b3 + hstepB, voffB); PG8_STAGE(PG8_SA(1, 0), a3, voffA);
            PG8_WAIT_V(8); PG8_WAIT_L(0); PG8_BAR; PG8_MMA(1, 0, At, B0); PG8_MMA(1, 1, At, B1); PG8_BAR; PG8_SCHED;
        }
        if constexpr (ALIGN_EPI) { if (wr == 0) PG8_BAR; }
        { int fr_ = fr, fq_ = fq; asm volatile("" : "+v"(fr_), "+v"(fq_)); E(acc, cur, wr, wc, fr_, fq_); }
        if (!has_next) break;
#pragma unroll
        for (int a = 0; a < 2; ++a)
#pragma unroll
            for (int b = 0; b < 2; ++b)
#pragma unroll
                for (int m = 0; m < 4; ++m)
#pragma unroll
                    for (int n = 0; n < 2; ++n) acc[a][b][m][n] = (f32x4){0.f, 0.f, 0.f, 0.f};
        cur = nxt; cA = nA; cB = nB; ++ui;
        if constexpr (ALIGN_EPI) { if (wr == 1) PG8_BAR; }
    }
    PG8_WAIT_V(0);
    if constexpr (!ALIGN_EPI) { if (wr == 0) PG8_BAR; }
    PG8_BAR;
#undef PG8_SA
#undef PG8_SB
#undef PG8_STAGE
#undef PG8_LDA
#undef PG8_LDB
#undef PG8_MMA
#undef PG8_WAIT_V
#undef PG8_WAIT_L
#undef PG8_BAR
#undef PG8_SCHED
#undef PG8_APTR
}
}

using pg8::f32x4; using pg8::u32x4; using pg8::u32x2;
typedef f32x4 AccT[2][2][4][2];
__device__ __forceinline__ float fq_sum(float v) {
    v += __builtin_bit_cast(float, __builtin_amdgcn_ds_swizzle(__builtin_bit_cast(int, v), 0x401f));
    float lo, hi; swap32(v, lo, hi); return lo + hi;
}
__device__ __forceinline__ void st16(bf16* p, u32x4 v) { *(u32x4*)p = v; }

struct EpiIn {
    static constexpr bool PERM = true;
    Ctx C;
    __device__ __forceinline__ void operator()(const AccT& acc, const pg8::Unit& u, int wr, int wc, int fr, int fq) const {
        const int tile = u.pn; const bool lat = u.pm < ML / 256; const int l = C.layer;
        if (tile < 4) {
            const bool isB = tile >= 2, qt = (tile & 1) == 0; const bool isq = qt, isk = !qt && wc < 2;
            const int hh = qt ? wc : (wc & 1);
            f32x4 gn[2][2];
            if (isB && !(!isq && !isk)) { const float* g = (isq ? C.p.q_norm_b : C.p.k_norm_b) + l * 64;
#pragma unroll
                for (int bj = 0; bj < 2; ++bj)
#pragma unroll
                    for (int n = 0; n < 2; ++n) gn[bj][n] = *(const f32x4*)(g + 32 * bj + 8 * fq + 4 * n); }
#pragma unroll
            for (int ai = 0; ai < 2; ++ai)
#pragma unroll
                for (int m = 0; m < 4; ++m) {
                    int r = u.pm * 256 + ai * 128 + wr * 64 + m * 16 + fr; asm volatile("" : "+v"(r)); const RowInfo ri = row_info(r);
                    f32x4 x[2][2];
#pragma unroll
                    for (int bj = 0; bj < 2; ++bj)
#pragma unroll
                        for (int n = 0; n < 2; ++n) x[bj][n] = acc[ai][bj][m][n];
                    if (isq || isk) {
                        if (isB) { float ss = 0.f;
#pragma unroll
                            for (int bj = 0; bj < 2; ++bj)
#pragma unroll
                                for (int n = 0; n < 2; ++n) ss += (x[bj][n][0] * x[bj][n][0] + x[bj][n][1] * x[bj][n][1]) + (x[bj][n][2] * x[bj][n][2] + x[bj][n][3] * x[bj][n][3]);
                            ss = fq_sum(ss);
                            const float rs = rsqrtf(ss * (1.f / 64.f) + RMS_EPS);
#pragma unroll
                            for (int bj = 0; bj < 2; ++bj)
#pragma unroll
                                for (int n = 0; n < 2; ++n) x[bj][n] = x[bj][n] * rs * gn[bj][n]; }
                        if (lat) { const int pos = fq < 2 ? (ri.t >> 6) : (ri.t & 63); const float2* tb = C.T64 + pos * 16 + 8 * (fq & 1);
#pragma unroll
                            for (int n = 0; n < 2; ++n) { const f32x4 cs0 = *(const f32x4*)(tb + 4 * n), cs1 = *(const f32x4*)(tb + 4 * n + 2);
                                const float cc[4] = {cs0[0], cs0[2], cs1[0], cs1[2]}, sn[4] = {cs0[1], cs0[3], cs1[1], cs1[3]};
#pragma unroll
                                for (int e = 0; e < 4; ++e) { const float x1 = x[0][n][e], x2 = x[1][n][e]; x[0][n][e] = x1 * cc[e] - x2 * sn[e]; x[1][n][e] = x1 * sn[e] + x2 * cc[e]; } } }
                    }
                    if (isq) { bf16* q = (isB ? C.QB() : C.QA()) + (size_t)r * 256 + hh * 64 + 8 * fq;
                        st16(q, pg8::pack8(x[0][0] * C2AB, x[0][1] * C2AB)); st16(q + 32, pg8::pack8(x[1][0] * C2AB, x[1][1] * C2AB)); }
                    else if (isk) { bf16* k = isB ? C.KB(ri.b, hh) : C.KA(ri.b, hh);
                        st16(k + kimg(ri.krow, 8 * fq), pg8::pack8(x[0][0], x[0][1])); st16(k + kimg(ri.krow, 32 + 8 * fq), pg8::pack8(x[1][0], x[1][1])); }
                    else { bf16* v = isB ? C.VB(ri.b, hh) : C.VA(ri.b, hh);
                        st16(v + vimg(ri.krow, 8 * fq), pg8::pack8(x[0][0], x[0][1])); st16(v + vimg(ri.krow, 32 + 8 * fq), pg8::pack8(x[1][0], x[1][1])); }
                    asm volatile("" ::: "memory");
                }
        } else if (tile == 4) {
#pragma unroll
            for (int ai = 0; ai < 2; ++ai)
#pragma unroll
                for (int m = 0; m < 4; ++m) {
                    int r = u.pm * 256 + ai * 128 + wr * 64 + m * 16 + fr; asm volatile("" : "+v"(r)); float ss = 0.f; bf16* o = C.AUP() + (size_t)r * 512 + 32 * wc + 8 * fq;
#pragma unroll
                    for (int bj = 0; bj < 2; ++bj) { const f32x4 a = acc[ai][bj][m][0], b = acc[ai][bj][m][1];
                        ss += (a[0] * a[0] + a[1] * a[1]) + (a[2] * a[2] + a[3] * a[3]) + (b[0] * b[0] + b[1] * b[1]) + (b[2] * b[2] + b[3] * b[3]);
                        st16(o + 128 * bj, pg8::pack8(a, b)); }
                    ss = fq_sum(ss);
                    if (fq == 0) C.SSQ[(size_t)r * 8 + wc] = ss;
                }
        } else {
#pragma unroll
            for (int ai = 0; ai < 2; ++ai)
#pragma unroll
                for (int m = 0; m < 4; ++m) {
                    int r = u.pm * 256 + ai * 128 + wr * 64 + m * 16 + fr; asm volatile("" : "+v"(r)); const RowInfo ri = row_info(r); bf16* o = C.AUP() + (size_t)r * 512 + 256 + 32 * wc + 8 * fq;
                    const f32x4 a = acc[ai][0][m][0], b = acc[ai][0][m][1];
                    float ss = (a[0] * a[0] + a[1] * a[1]) + (a[2] * a[2] + a[3] * a[3]) + (b[0] * b[0] + b[1] * b[1]) + (b[2] * b[2] + b[3] * b[3]);
                    st16(o, pg8::pack8(a, b)); { unsigned z = 0u; asm volatile("" : "+v"(z)); st16(o + 128, (u32x4){z, z, z, z}); }
                    ss = fq_sum(ss);
                    if (fq == 0) C.SSQ[(size_t)r * 8 + 4 + wc] = ss;
                    if (wc == 0) {
                        f32x4 x1 = acc[ai][1][m][0], x2 = acc[ai][1][m][1];
                        if (lat) { const int pos = fq < 2 ? (ri.t >> 6) : (ri.t & 63); const float2* tb = C.T32 + pos * 8 + 4 * (fq & 1);
                            const f32x4 cs0 = *(const f32x4*)(tb), cs1 = *(const f32x4*)(tb + 2); const float cc[4] = {cs0[0], cs0[2], cs1[0], cs1[2]}, sn[4] = {cs0[1], cs0[3], cs1[1], cs1[3]};
#pragma unroll
                            for (int e = 0; e < 4; ++e) { const float p = x1[e], q = x2[e]; x1[e] = p * cc[e] - q * sn[e]; x2[e] = p * sn[e] + q * cc[e]; } }
                        bf16* k = C.KR(ri.b);
                        *(u32x2*)(k + krimg(ri.krow, 4 * fq)) = (u32x2){pg8::cvt_pk_bf16(x1[0], x1[1]), pg8::cvt_pk_bf16(x1[2], x1[3])};
                        *(u32x2*)(k + krimg(ri.krow, 16 + 4 * fq)) = (u32x2){pg8::cvt_pk_bf16(x2[0], x2[1]), pg8::cvt_pk_bf16(x2[2], x2[3])};
                    }
                    asm volatile("" ::: "memory");
                }
        }
    }
};
struct EpiUp {
    static constexpr bool PERM = true;
    Ctx C;
    __device__ __forceinline__ void operator()(const AccT& acc, const pg8::Unit& u, int wr, int wc, int fr, int fq) const {
        const int tile = u.pn; const bool lat = u.pm < ML / 256;
#pragma unroll
        for (int ai = 0; ai < 2; ++ai)
#pragma unroll
            for (int m = 0; m < 4; ++m) {
                int r = u.pm * 256 + ai * 128 + wr * 64 + m * 16 + fr; asm volatile("" : "+v"(r)); const RowInfo ri = row_info(r);
                const f32x4 s0 = *(const f32x4*)(C.SSQ + (size_t)r * 8), s1 = *(const f32x4*)(C.SSQ + (size_t)r * 8 + 4);
                if (tile < 3) {
                    const float sc = rsqrtf(((s0[0] + s0[1]) + (s0[2] + s0[3])) * (1.f / 256.f) + RMS_EPS) * C2C;
                    if (tile < 2) { bf16* q = C.QC() + (size_t)r * 768 + (4 * tile + wc) * 96 + 8 * fq;
                        st16(q, pg8::pack8(acc[ai][0][m][0] * sc, acc[ai][0][m][1] * sc)); st16(q + 32, pg8::pack8(acc[ai][1][m][0] * sc, acc[ai][1][m][1] * sc)); }
                    else { bf16* q = C.QC() + (size_t)r * 768 + (2 * wc + (fq >> 1)) * 96 + 64 + 8 * (fq & 1);
                        const int pos = (fq & 1) == 0 ? (ri.t >> 6) : (ri.t & 63); const float2* tb = C.T32 + pos * 8;
#pragma unroll
                        for (int n = 0; n < 2; ++n) { f32x4 x1 = acc[ai][0][m][n], x2 = acc[ai][1][m][n];
                            if (lat) { const f32x4 cs0 = *(const f32x4*)(tb + 4 * n), cs1 = *(const f32x4*)(tb + 4 * n + 2); const float cc[4] = {cs0[0], cs0[2], cs1[0], cs1[2]}, sn[4] = {cs0[1], cs0[3], cs1[1], cs1[3]};
#pragma unroll
                                for (int e = 0; e < 4; ++e) { const float p = x1[e], qq = x2[e]; x1[e] = p * cc[e] - qq * sn[e]; x2[e] = p * sn[e] + qq * cc[e]; } }
                            x1 = x1 * sc; x2 = x2 * sc;
                            *(u32x2*)(q + 4 * n) = (u32x2){pg8::cvt_pk_bf16(x1[0], x1[1]), pg8::cvt_pk_bf16(x1[2], x1[3])};
                            *(u32x2*)(q + 16 + 4 * n) = (u32x2){pg8::cvt_pk_bf16(x2[0], x2[1]), pg8::cvt_pk_bf16(x2[2], x2[3])};
                            asm volatile("" ::: "memory"); } }
                } else {
                    const float sc = rsqrtf(((s1[0] + s1[1]) + (s1[2] + s1[3])) * (1.f / 128.f) + RMS_EPS);
                    const bool isk = tile < 5; const int h = 4 * ((tile - 3) & 1) + wc; bf16* o = isk ? C.KC(ri.b, h) : C.VC(ri.b, h);
                    const size_t o0 = isk ? kimg(ri.krow, 8 * fq) : vimg(ri.krow, 8 * fq), o1 = isk ? kimg(ri.krow, 32 + 8 * fq) : vimg(ri.krow, 32 + 8 * fq);
                    st16(o + o0, pg8::pack8(acc[ai][0][m][0] * sc, acc[ai][0][m][1] * sc)); st16(o + o1, pg8::pack8(acc[ai][1][m][0] * sc, acc[ai][1][m][1] * sc));
                }
                asm volatile("" ::: "memory");
            }
    }
};
struct EpiRes {
    static constexpr bool PERM = false;
    Ctx C; int which_gate; bool first;
    __device__ __forceinline__ void operator()(const AccT& acc, const pg8::Unit& u, int wr, int wc, int fr, int fq) const {
        const int set = u.pm < 32 ? 0 : (u.pm < 64 ? 1 : 2); const float* g = C.mod(set, which_gate); const int col0 = u.pn * 256 + wc * 32 + 4 * fq;
        f32x4 gv[2][2];
#pragma unroll
        for (int bj = 0; bj < 2; ++bj)
#pragma unroll
            for (int n = 0; n < 2; ++n) gv[bj][n] = *(const f32x4*)(g + col0 + bj * 128 + n * 16);
#pragma unroll
        for (int ai = 0; ai < 2; ++ai)
#pragma unroll
            for (int m = 0; m < 4; ++m) {
                int r = u.pm * 256 + ai * 128 + wr * 64 + m * 16 + fr; asm volatile("" : "+v"(r)); const float* base = (first ? C.resid_in(r) : C.resid(r)) + col0; float* o = C.resid(r) + col0;
#pragma unroll
                for (int bj = 0; bj < 2; ++bj)
#pragma unroll
                    for (int n = 0; n < 2; ++n) { const f32x4 bs = *(const f32x4*)(base + bj * 128 + n * 16); *(f32x4*)(o + bj * 128 + n * 16) = bs * ALPHA + gv[bj][n] * acc[ai][bj][m][n]; }
            }
    }
};
struct EpiRelu2 {
    static constexpr bool PERM = true;
    bf16* O;
    __device__ __forceinline__ void operator()(const AccT& acc, const pg8::Unit& u, int wr, int wc, int fr, int fq) const {
#pragma unroll
        for (int ai = 0; ai < 2; ++ai)
#pragma unroll
            for (int m = 0; m < 4; ++m) { int r = u.pm * 256 + ai * 128 + wr * 64 + m * 16 + fr; asm volatile("" : "+v"(r)); bf16* rowp = O + (size_t)r * DFF + u.pn * 256 + wc * 32 + 8 * fq;
#pragma unroll
                for (int bj = 0; bj < 2; ++bj) { f32x4 a = acc[ai][bj][m][0], b = acc[ai][bj][m][1];
#pragma unroll
                    for (int e = 0; e < 4; ++e) { const float p = fmaxf(a[e], 0.f), q = fmaxf(b[e], 0.f); a[e] = p * p; b[e] = q * q; }
                    st16(rowp + bj * 128, pg8::pack8(a, b)); } }
    }
};

__device__ __forceinline__ int win_src(int n) {
    const int tile = n >> 8, c = n & 255, bj = c >> 7, wc = (c >> 5) & 3, d = 32 * bj + (c & 31);
    switch (tile) {
        case 0: return wc * 64 + d;
        case 1: return (wc < 2 ? 256 + wc * 64 : 384 + (wc - 2) * 64) + d;
        case 2: return 512 + wc * 64 + d;
        case 3: return (wc < 2 ? 768 + wc * 64 : 896 + (wc - 2) * 64) + d;
        case 4: return 1024 + c;
        default: if (c < 128) return 1280 + c; if (c < 160) { const int e = (c - 128) & 7, fq = (c - 128) >> 3; return 1408 + (e < 4 ? 4 * fq + e : 16 + 4 * fq + (e - 4)); } return -1;
    }
}
__device__ __forceinline__ int wuq_src(int n) {
    const int tile = n >> 8, c = n & 255, bj = c >> 7, wc = (c >> 5) & 3, i = c & 31;
    if (tile < 2) return (4 * tile + wc) * 96 + 32 * bj + i;
    return (2 * wc + (i >> 4)) * 96 + 64 + 16 * bj + (i & 15);
}
__device__ __forceinline__ int wukv_src(int n) {
    const int tile = n >> 8, c = n & 255, bj = c >> 7, wc = (c >> 5) & 3, i = c & 31;
    return (4 * tile + wc) * 64 + 32 * bj + i;
}
__device__ __forceinline__ void conv_item(const float* W, int Ks, int Ns, bf16* WT, int Kd, int row_off, int mode, const float* kscale, __attribute__((address_space(3))) float* scr, int kb, int nb, int lane) {
    const int k0 = 64 * kb, n0 = 32 * nb; const int nn = n0 + (lane & 31);
    const int sc = mode == 0 ? nn : mode == 1 ? win_src(nn) : mode == 2 ? wuq_src(nn) : wukv_src(nn);
#pragma unroll 8
    for (int i = 0; i < 32; ++i) { const int kk = 2 * i + (lane >> 5), k = k0 + kk; float v = 0.f; if (sc >= 0 && k < Ks) { v = W[(size_t)k * Ns + sc]; if (kscale) v *= kscale[k]; } scr[kk * 33 + (lane & 31)] = v; }
    asm volatile("s_waitcnt lgkmcnt(0)" ::: "memory");
    const int c = lane & 7;
#pragma unroll
    for (int j = 0; j < 4; ++j) { const int n = (lane >> 3) + 8 * j; const __attribute__((address_space(3))) float* s = scr + (8 * c) * 33 + n;
        u32x4 o; o.x = f2bf(s[0]) | (f2bf(s[33]) << 16); o.y = f2bf(s[66]) | (f2bf(s[99]) << 16); o.z = f2bf(s[132]) | (f2bf(s[165]) << 16); o.w = f2bf(s[198]) | (f2bf(s[231]) << 16);
        *(u32x4*)(WT + (size_t)(row_off + n0 + n) * Kd + k0 + 8 * c) = o; }
    asm volatile("s_waitcnt lgkmcnt(0)" ::: "memory");
}
__device__ __forceinline__ bf16* wts(const Params& p, int l, size_t off) { return (bf16*)(p.ws + WS_W + (size_t)l * W_LAYER + off); }
__device__ __forceinline__ void ph_prologue(const Ctx& C, unsigned char* ldsb) {
    const Params& p = C.p; const int tid = C.tid(), lane = tid & 63, wave = C.wave;
    { float* red = (float*)ldsb;
      for (int task = obid(); task < DEPTH * (DMOD / 64); task += ogrid()) {
        const int l = task / (DMOD / 64), n = (task % (DMOD / 64)) * 64 + lane; const float* w = p.w_mod + (size_t)l * D * DMOD + n;
        float a0 = 0.f, a1 = 0.f, a2 = 0.f;
#pragma unroll 8
        for (int kk = 0; kk < 128; ++kk) { const int k = wave * 128 + kk; const float wv = w[(size_t)k * DMOD];
            a0 += nv::silu(p.c[k]) * wv; a1 += nv::silu(p.c[D + k]) * wv; a2 += nv::silu(p.c_ctx[k]) * wv; }
        __syncthreads();
        red[(wave * 3 + 0) * 64 + lane] = a0; red[(wave * 3 + 1) * 64 + lane] = a1; red[(wave * 3 + 2) * 64 + lane] = a2;
        __syncthreads();
        if (tid < 192) { const int s = tid >> 6; float acc = p.b_mod[l * DMOD + n];
#pragma unroll
            for (int wv = 0; wv < 8; ++wv) acc += red[(wv * 3 + s) * 64 + lane];
            C.MOD[(size_t)(l * 3 + s) * DMOD + n] = acc; }
      }
      __syncthreads();
    }
    const int gtid = obid() * NTHREADS + tid, gsz = ogrid() * NTHREADS;
    for (int idx = gtid; idx < 128 * 16; idx += gsz) { const int pos = idx >> 4, j = idx & 15; const float inv = powf(10000.f, -(float)j / 16.f), a = (float)pos * inv; C.T64[idx] = make_float2(cosf(a), sinf(a)); }
    for (int idx = gtid; idx < 128 * 8; idx += gsz) { const int pos = idx >> 3, j = idx & 7; const float inv = powf(10000.f, -(float)j / 8.f), a = (float)pos * inv; C.T32[idx] = make_float2(cosf(a), sinf(a)); }
    __attribute__((address_space(3))) float* scr = (__attribute__((address_space(3))) float*)(ldsb) + wave * (64 * 33);
    const int gw = obid() * (NTHREADS / 64) + wave, ngw = ogrid() * (NTHREADS / 64);
    constexpr int I_IN = 16 * 48, I_UQ = 4 * 24, I_UKV = 4 * 16, I_OUT = 16 * 32, I_FC1 = 16 * 128, I_FC2 = 64 * 32;
    constexpr int I_L = I_IN + I_UQ + 2 * I_UKV + I_OUT + I_FC1 + I_FC2;
    for (int it = gw; it < DEPTH * I_L; it += ngw) {
        const int l = it / I_L; int r = it % I_L;
        if (r < I_IN) { conv_item(p.w_in + (size_t)l * D * DIN, D, DIN, wts(p, l, W_IN), D, 0, 1, nullptr, scr, r / 48, r % 48, lane); continue; } r -= I_IN;
        if (r < I_UQ) { conv_item(p.w_uq + (size_t)l * 256 * 768, 256, 768, wts(p, l, W_UP), 256, 0, 2, p.mla_q_norm + l * 256, scr, r / 24, r % 24, lane); continue; } r -= I_UQ;
        if (r < I_UKV) { conv_item(p.w_uk + (size_t)l * 128 * 512, 128, 512, wts(p, l, W_UP), 256, 768, 3, p.mla_kv_norm + l * 128, scr, r / 16, r % 16, lane); continue; } r -= I_UKV;
        if (r < I_UKV) { conv_item(p.w_uv + (size_t)l * 128 * 512, 128, 512, wts(p, l, W_UP), 256, 1280, 3, p.mla_kv_norm + l * 128, scr, r / 16, r % 16, lane); continue; } r -= I_UKV;
        if (r < I_OUT) { conv_item(p.w_out + (size_t)l * D * D, D, D, wts(p, l, W_OUT), D, 0, 0, nullptr, scr, r / 32, r % 32, lane); continue; } r -= I_OUT;
        if (r < I_FC1) { conv_item(p.w_fc1 + (size_t)l * D * DFF, D, DFF, wts(p, l, W_FC1), D, 0, 0, nullptr, scr, r / 128, r % 128, lane); continue; } r -= I_FC1;
        conv_item(p.w_fc2 + (size_t)l * DFF * D, DFF, D, wts(p, l, W_FC2), DFF, 0, 0, nullptr, scr, r / 32, r % 32, lane);
    }
}


#define LAS __attribute__((address_space(3)))
constexpr int RING_BYTES = 131072, LDSCTL_OFF = RING_BYTES, MISC_OFF = LDSCTL_OFF + 320, LDS_BYTES = 147456;
constexpr int CW_BAR = 4096;
#define XB_TMO      128
#define XB_XCNT(j)  (256  + 64 * (j))
#define XB_XSUB(j)  (1280 + 64 * (j))
#define XB_XGEN(j)  (2304 + 64 * (j))
#define XB_TOP      3328
#define XB_TOPGEN   3392
#define XB_SPIN_CAP (1u << 20)
__device__ __forceinline__ unsigned xb_ld(unsigned* p)              { return __hip_atomic_load(p, __ATOMIC_RELAXED, __HIP_MEMORY_SCOPE_AGENT); }
__device__ __forceinline__ unsigned xb_add(unsigned* p, unsigned v) { return __hip_atomic_fetch_add(p, v, __ATOMIC_RELAXED, __HIP_MEMORY_SCOPE_AGENT); }
__device__ __forceinline__ unsigned xb_xcc_id() { return (unsigned)__builtin_amdgcn_s_getreg((3 << 11) | 20) & 0xFu; }
#define XB_SPIN(cond, bar) do { unsigned _sp = 0; while (cond) { __builtin_amdgcn_s_sleep(1); \
    if ((++_sp & 255u) == 0u) { if (xb_ld(&(bar)[XB_TMO])) break; if (_sp > XB_SPIN_CAP) { atomicAdd(&(bar)[XB_TMO], 1u); break; } } } } while (0)
struct XcdBarrier { unsigned* bar; unsigned x; volatile LAS unsigned* st; };
__device__ __forceinline__ XcdBarrier xcd_barrier_post(unsigned* bar, volatile LAS unsigned* st, int tid) {
    XcdBarrier b; b.bar = bar; b.x = 0; b.st = st;
    if (tid == 0) (void)xb_add(&bar[XB_XCNT(__builtin_amdgcn_readfirstlane(xb_xcc_id()))], 1u);
    return b;
}
__device__ __forceinline__ void xcd_barrier_complete(unsigned* bar, unsigned x, unsigned& nloc, unsigned& nx) {
    const unsigned G = gridDim.x * gridDim.y * gridDim.z;
    unsigned sum, cnt, mine, sp = 0u;
    for (;;) {
        sum = 0u; cnt = 0u; mine = 0u;
#pragma unroll
        for (unsigned j = 0; j < 16; ++j) { const unsigned c = xb_ld(&bar[XB_XCNT(j)]); sum += c; cnt += (c > 0u) ? 1u : 0u; mine = (j == x) ? c : mine; }
        if (sum == G) break;
        __builtin_amdgcn_s_sleep(1);
        if ((++sp & 255u) == 0u) { if (xb_ld(&bar[XB_TMO])) break; if (sp > XB_SPIN_CAP) { atomicAdd(&bar[XB_TMO], 1u); break; } }
    }
    nloc = mine > 0u ? mine : 1u; nx = cnt > 0u ? cnt : 1u;
}
__device__ __forceinline__ void xcd_barrier(const XcdBarrier& b, int tid) {
    asm volatile("s_waitcnt vmcnt(0)" ::: "memory");
    __syncthreads();
    if (tid == 0) {
        unsigned* bar = b.bar; const unsigned bx = (unsigned)__builtin_amdgcn_readfirstlane(xb_xcc_id());
        __builtin_amdgcn_s_waitcnt(0);
        unsigned nloc = b.st[0], nx = b.st[1];
        if (nloc == 0u) { xcd_barrier_complete(bar, bx, nloc, nx); b.st[0] = nloc; b.st[1] = nx; }
        const unsigned old = xb_add(&bar[XB_XSUB(bx)], 1u);
        const unsigned gen = old / nloc;
        if (old + 1u == (gen + 1u) * nloc) {
            __builtin_amdgcn_fence(__ATOMIC_RELEASE, "agent");
            asm volatile("s_waitcnt vmcnt(0)" ::: "memory");
            const unsigned og = xb_add(&bar[XB_TOP], 1u);
            const unsigned tg = og / nx;
            if (og + 1u == (tg + 1u) * nx) xb_add(&bar[XB_TOPGEN], 1u);
            else XB_SPIN(xb_ld(&bar[XB_TOPGEN]) == tg, bar);
            __builtin_amdgcn_fence(__ATOMIC_ACQUIRE, "agent");
            xb_add(&bar[XB_XGEN(bx)], 1u);
            asm volatile("s_waitcnt vmcnt(0)" ::: "memory");
        } else {
            XB_SPIN(xb_ld(&bar[XB_XGEN(bx)]) == gen, bar);
            __builtin_amdgcn_fence(__ATOMIC_ACQUIRE, "agent");
            asm volatile("s_waitcnt vmcnt(0)" ::: "memory");
        }
    }
    __syncthreads();
}


namespace fa {
typedef short bf16x8 __attribute__((ext_vector_type(8)));
typedef short s16x4 __attribute__((ext_vector_type(4)));
typedef short v4i16_t __attribute__((ext_vector_type(4)));
typedef float f32x16 __attribute__((ext_vector_type(16)));
typedef float f32x2_t __attribute__((ext_vector_type(2))); typedef __bf16 bf16x2_t __attribute__((ext_vector_type(2)));
constexpr int KBUF = 12288, VBUF = 8192, BUFB = KBUF + VBUF, NSLOT = 4, OFF_WS = NSLOT * BUFB, OFF_OST = OFF_WS + 8 * 256, LDS_TOTAL = OFF_OST + 8 * 4096;
static_assert(LDS_TOTAL <= RING_BYTES, "attention LDS");
constexpr float THR = 8.f;
__device__ __forceinline__ int crow(int r, int hi) { return (r & 3) + 8 * (r >> 2) + 4 * hi; }
__device__ __forceinline__ unsigned cvtpk(float lo, float hi) { f32x2_t v = {lo, hi}; bf16x2_t b = __builtin_convertvector(v, bf16x2_t); return __builtin_bit_cast(unsigned, b); }
__device__ __forceinline__ s16x4 vtr(const LAS unsigned char* p) { return __builtin_bit_cast(s16x4, __builtin_amdgcn_ds_read_tr16_b64_v4i16((LAS v4i16_t*)p)); }
__device__ __forceinline__ float max3f(float a, float b, float c) { float r; asm("v_max3_f32 %0, %1, %2, %3" : "=v"(r) : "v"(a), "v"(b), "v"(c)); return r; }
__device__ __forceinline__ float max2f(float a, float b) { float r; asm("v_max_f32_e32 %0, %1, %2" : "=v"(r) : "v"(a), "v"(b)); return r; }
__device__ __forceinline__ float swap_max(float m) { float lo, hi; swap32(m, lo, hi); return max2f(lo, hi); }
__device__ __forceinline__ float swap_sum(float m) { float lo, hi; swap32(m, lo, hi); return lo + hi; }
__device__ __forceinline__ void glds16(const void* gbase  , unsigned voff  , unsigned lds_dst  ) { unsigned keep;
    asm volatile("s_mov_b32 %0, m0\n\ts_mov_b32 m0, %3\n\ts_nop 0\n\tglobal_load_lds_dwordx4 %1, %2\n\ts_mov_b32 m0, %0" : "=&s"(keep) : "v"(voff), "s"(gbase), "s"(lds_dst) : "memory"); }
#define FA_BAR() asm volatile("s_waitcnt lgkmcnt(0)\n\ts_barrier" ::: "memory")
#define FA_WAITV(N) asm volatile("s_waitcnt vmcnt(" #N ")" ::: "memory")

template <int DQK, bool MASK>
__device__ __forceinline__ void attn_unit(const Ctx& C, LAS unsigned char* lds, const int tid, const int type, const int b, const int h, const int row0, const int qpos0, const int tlo, const int thi) {
    constexpr int ND0 = DQK / 16;
    const int lane = tid & 63, wid = __builtin_amdgcn_readfirstlane(tid >> 6), r32 = lane & 31, hi = lane >> 5;
    const bool trailing = wid >= 4;
    const int kvh = type == 2 ? h : (h >> 1);
    const bf16* Kimg = type == 0 ? C.KA(b, kvh) : type == 1 ? C.KB(b, kvh) : C.KC(b, kvh);
    const bf16* Vimg = type == 0 ? C.VA(b, kvh) : type == 1 ? C.VB(b, kvh) : C.VC(b, kvh);
    const bf16* KRimg = C.KR(b);
    const int qrow = row0 + wid * 32 + r32;
    const bf16* Q = type == 0 ? C.QA() + (size_t)qrow * 256 + h * 64 : type == 1 ? C.QB() + (size_t)qrow * 256 + h * 64 : C.QC() + (size_t)qrow * 768 + h * 96;
    bf16x8 qr[ND0];
#pragma unroll
    for (int d0 = 0; d0 < ND0; ++d0) qr[d0] = *(const bf16x8*)(Q + 16 * d0 + 8 * hi);
    const int n = 4 + (thi - tlo);
    const unsigned lds0 = (unsigned)(uintptr_t)lds, lane16 = (unsigned)lane * 16u;
#define FA_ISSUE(j) do { const int j_ = (j); const int tt_ = j_ < 4 ? j_ : tlo + (j_ - 4); const unsigned sl_ = lds0 + (unsigned)(j_ & 3) * BUFB; \
        glds16(Kimg + (size_t)tt_ * 4096 + wid * 512, lane16, (unsigned)__builtin_amdgcn_readfirstlane((int)(sl_ + wid * 1024))); \
        glds16(Vimg + (size_t)tt_ * 4096 + wid * 512, lane16, (unsigned)__builtin_amdgcn_readfirstlane((int)(sl_ + KBUF + wid * 1024))); \
        if (DQK == 96) glds16(KRimg + (size_t)tt_ * 2048 + (wid & 3) * 512, lane16, (unsigned)__builtin_amdgcn_readfirstlane((int)(sl_ + 8192 + (wid & 3) * 1024))); } while (0)
#define FA_WAIT_KEEP1() do { FA_WAITV(0); } while (0)
    f32x16 o[2]; o[0] = f32x16{}; o[1] = f32x16{};
    float mhat = 0.f, lsum = 0.f;
    LAS float* wsf = (LAS float*)(lds + OFF_WS) + wid * 64;
    const int koff = hi * 1024 + r32 * 16;
    const int voff = KBUF + ((lane >> 4) & 1) * 32 + (lane & 3) * 8 + (4 * hi + ((lane & 15) >> 2)) * 64;
    const int qpos = qpos0 + wid * 32 + r32;
    bf16x8 kf[2 * ND0]; s16x4 vlo[8], vhh[8]; u32x4 pw[4]; f32x16 p0, p1;
#define FA_LDK(j) do { const LAS unsigned char* kb_ = lds + ((j) & 3) * BUFB + koff; _Pragma("unroll") for (int d0 = 0; d0 < ND0; ++d0) { kf[2 * d0] = *(const LAS bf16x8*)(kb_ + d0 * 2048); kf[2 * d0 + 1] = *(const LAS bf16x8*)(kb_ + d0 * 2048 + 512); } } while (0)
#define FA_LDV(j) do { const LAS unsigned char* vb_ = lds + ((j) & 3) * BUFB + voff; _Pragma("unroll") for (int q_ = 0; q_ < 8; ++q_) { vlo[q_] = vtr(vb_ + (q_ >> 2) * 4096 + (q_ & 3) * 1024); vhh[q_] = vtr(vb_ + (q_ >> 2) * 4096 + (q_ & 3) * 1024 + 512); } } while (0)
#define FA_PV() do { _Pragma("unroll") for (int d0 = 0; d0 < 2; ++d0) _Pragma("unroll") for (int ks = 0; ks < 4; ++ks) { const s16x4 lo_ = vlo[d0 * 4 + ks], hh_ = vhh[d0 * 4 + ks]; \
        const bf16x8 vf_ = (bf16x8){lo_[0], lo_[1], lo_[2], lo_[3], hh_[0], hh_[1], hh_[2], hh_[3]}; o[d0] = __builtin_amdgcn_mfma_f32_32x32x16_bf16(__builtin_bit_cast(bf16x8, pw[ks]), vf_, o[d0], 0, 0, 0); } } while (0)
    FA_ISSUE(0); FA_ISSUE(1);
    FA_WAIT_KEEP1();
    FA_BAR();
    if (trailing) { FA_ISSUE(2); FA_WAIT_KEEP1(); FA_BAR(); }
    for (int j = 0; j < n; ++j) {
        if (!trailing) { if (j + 2 < n) FA_ISSUE(j + 2); }
        FA_LDK(j);
        { const float nm = -mhat;
#pragma unroll
            for (int r = 0; r < 16; ++r) { p0[r] = nm; p1[r] = nm; } }
        __builtin_amdgcn_s_setprio(1);
        if (j > 0) FA_PV();
#pragma unroll
        for (int d0 = 0; d0 < ND0; ++d0) {
            p0 = __builtin_amdgcn_mfma_f32_32x32x16_bf16(kf[2 * d0], qr[d0], p0, 0, 0, 0); p1 = __builtin_amdgcn_mfma_f32_32x32x16_bf16(kf[2 * d0 + 1], qr[d0], p1, 0, 0, 0);
        }
        __builtin_amdgcn_s_setprio(0);
        if (!trailing) { if (j + 2 < n) FA_WAIT_KEEP1(); else FA_WAITV(0); }
        FA_BAR();
        if (trailing) { if (j + 3 < n) FA_ISSUE(j + 3); }
        FA_LDV(j);
        const int tcur = j < 4 ? j : tlo + (j - 4);
        if (MASK && tcur >= 4) { const int rel0 = (tcur - 4) * 64 + 4 * hi - qpos;
#pragma unroll
            for (int r = 0; r < 16; ++r) { const int rel = rel0 + (r & 3) + 8 * (r >> 2); if (rel > 128 || rel < -128) p0[r] = -INFINITY; if (rel + 32 > 128 || rel + 32 < -128) p1[r] = -INFINITY; } }
        asm volatile("s_nop 7\n\ts_nop 7" : "+v"(p0), "+v"(p1));
        float ra = max3f(p0[0], p0[1], p1[0]), rb = max3f(p0[2], p0[3], p1[1]); ra = max3f(ra, p1[2], p1[3]);
#pragma unroll
        for (int r = 4; r < 16; r += 4) { ra = max3f(ra, p0[r], p0[r + 1]); rb = max3f(rb, p0[r + 2], p0[r + 3]); ra = max3f(ra, p1[r], p1[r + 1]); rb = max3f(rb, p1[r + 2], p1[r + 3]); }
        const float rm = swap_max(max2f(ra, rb));
        const bool first = (j == 0);
        if (first || __any(rm > THR)) {
            const float dl = first ? rm : max2f(rm, 0.f);
            mhat += dl;
#pragma unroll
            for (int r = 0; r < 16; ++r) { p0[r] -= dl; p1[r] -= dl; }
            if (!first) { const float f = __builtin_amdgcn_exp2f(-dl); lsum *= f; if (hi == 0) wsf[r32] = f;
#pragma unroll
                for (int r = 0; r < 16; ++r) { const float fr_ = wsf[crow(r, hi)]; o[0][r] *= fr_; o[1][r] *= fr_; } }
        }
        float sacc = 0.f;
#pragma unroll
        for (int r = 0; r < 16; ++r) { p0[r] = __builtin_amdgcn_exp2f(p0[r]); p1[r] = __builtin_amdgcn_exp2f(p1[r]); sacc += p0[r] + p1[r]; }
        lsum += sacc;
#pragma unroll
        for (int q_ = 0; q_ < 4; ++q_) { pw[0][q_] = cvtpk(p0[2 * q_], p0[2 * q_ + 1]); pw[1][q_] = cvtpk(p0[8 + 2 * q_], p0[9 + 2 * q_]); pw[2][q_] = cvtpk(p1[2 * q_], p1[2 * q_ + 1]); pw[3][q_] = cvtpk(p1[8 + 2 * q_], p1[9 + 2 * q_]); }
        if (trailing) { if (j + 3 < n) FA_WAIT_KEEP1(); else FA_WAITV(0); }
        FA_BAR();
    }
    FA_PV();
    if (!trailing) FA_BAR();
#undef FA_ISSUE
#undef FA_WAIT_KEEP1
#undef FA_LDK
#undef FA_LDV
#undef FA_PV
    float ltot = swap_sum(lsum);
    if (type == 0) ltot += __builtin_amdgcn_exp2f(C.p.sink_a[C.layer * 4 + h] * LOG2E - mhat);
    if (hi == 0) wsf[32 + r32] = 1.f / ltot;
    LAS unsigned short* stg = (LAS unsigned short*)(lds + OFF_OST + wid * 4096);
#pragma unroll
    for (int r = 0; r < 16; ++r) { const int orow = crow(r, hi); const float rl = wsf[32 + orow];
        stg[orow * 64 + r32] = (unsigned short)f2bf(o[0][r] * rl); stg[orow * 64 + 32 + r32] = (unsigned short)f2bf(o[1][r] * rl); }
    bf16* Yw = C.Y() + (size_t)(row0 + wid * 32) * D + (type == 0 ? 0 : type == 1 ? 256 : 512) + h * 64;
#pragma unroll
    for (int i = 0; i < 4; ++i) { const int row = i * 8 + (lane >> 3), ch = lane & 7; const u32x4 v = *(const LAS u32x4*)(stg + row * 64 + ch * 8); *(u32x4*)(Yw + (size_t)row * D + ch * 8) = v; }
    FA_WAITV(0);
    FA_BAR();
}
__device__ __forceinline__ void run_unit(const Ctx& C, LAS unsigned char* lds, int tid, int type, int b, int h, int qb  ) {
    if (qb < 0) { const int row0 = ML + b * CTX;
        if (type == 2) attn_unit<96, false>(C, lds, tid, 2, b, h, row0, 0, 4, 4); else attn_unit<64, false>(C, lds, tid, type, b, h, row0, 0, 4, 4); return; }
    const int q0 = qb * 256, row0 = b * SEQ + q0;
    if (type == 2) attn_unit<96, false>(C, lds, tid, 2, b, h, row0, q0, 4, NTILE);
    else if (type == 1) attn_unit<64, false>(C, lds, tid, 1, b, h, row0, q0, 4, NTILE);
    else { int lo = q0 - 128, hi_ = q0 + 384; if (lo < 0) lo = 0; if (hi_ > SEQ) hi_ = SEQ; attn_unit<64, true>(C, lds, tid, 0, b, h, row0, q0, 4 + lo / 64, 4 + hi_ / 64); }
}
__device__ __forceinline__ void ph_attn(const Ctx& C, LAS unsigned char* lds, int tid, bool with_ctx) {
    const int G = ogrid(), bx = obid();
    const int v = (G % 8 == 0) ? (bx % 8) * (G / 8) + bx / 8 : bx;
    for (int u = v; u < 256; u += G) {
        for (int i = 0; i < 2; ++i) { const int uc = 2 * u + i, pair = uc >> 5; run_unit(C, lds, tid, 2, pair >> 3, pair & 7, uc & 31); }
        run_unit(C, lds, tid, 1, u >> 7, (u >> 5) & 3, u & 31);
        run_unit(C, lds, tid, 0, u >> 7, (u >> 5) & 3, u & 31);
        if (with_ctx && (u & 7) == 0) { const int j = u >> 3;
            if (j < 8) run_unit(C, lds, tid, 0, j >> 2, j & 3, -1); else if (j < 16) run_unit(C, lds, tid, 1, (j - 8) >> 2, j & 3, -1); else run_unit(C, lds, tid, 2, (j - 16) >> 3, j & 7, -1); }
    }
}
}

__device__ __forceinline__ Ctx make_ctx(int layer, int wave) {
    typedef __attribute__((address_space(4))) const unsigned long long kw_t;
    kw_t* kp = (kw_t*)__builtin_amdgcn_kernarg_segment_ptr();
    asm volatile("" : "+s"(kp));
    Ctx C; unsigned long long* d = (unsigned long long*)&C.p;
#pragma unroll
    for (int i = 0; i < (int)(sizeof(Params) / 8); ++i) d[i] = (unsigned long long)(uintptr_t)(void*)(__attribute__((address_space(1))) void*)(uintptr_t)kp[i];
    C.layer = layer; C.wave = wave; unsigned char* ws = C.p.ws;
    C.MOD = (float*)(ws + WS_MOD); C.T64 = (float2*)(ws + WS_T64); C.T32 = (float2*)(ws + WS_T32); C.SSQ = (float*)(ws + WS_SSQ);
    C.RC = (float*)(ws + WS_RC); C.H = (bf16*)(ws + WS_H); C.R = ws + WS_R;
    return C;
}
__global__ void __launch_bounds__(NTHREADS, 2) fwd_kernel(Params p_unused) {
    extern __shared__ __attribute__((aligned(16))) unsigned char lds[];
    cg::grid_group grid = cg::this_grid();
    const int wave_s = __builtin_amdgcn_readfirstlane(threadIdx.x >> 6);
    const int gsz = ogrid() * NTHREADS;
#define TID otid(wave_s)
#define GTID ((int)(obid() * NTHREADS) + otid(wave_s))
#define CTX(l) make_ctx((l), wave_s)
    for (int u = threadIdx.x; u < (LDS_BYTES - LDSCTL_OFF) / 4; u += NTHREADS) ((LAS unsigned*)((LAS unsigned char*)lds + LDSCTL_OFF))[u] = 0u;
    __syncthreads();
    XcdBarrier bar;
    { const Ctx C = CTX(0); bar = xcd_barrier_post((unsigned*)(C.p.ws + WS_CTL) + CW_BAR, (volatile LAS unsigned*)((LAS unsigned char*)lds + MISC_OFF) + 8, TID); }
#define SEAM() xcd_barrier(bar, TID)
#ifndef SKIP_PRO
    { const Ctx C = CTX(0); ph_prologue(C, lds); }
#endif
    grid.sync();
    { const Ctx C = CTX(0); nv::ph_modulate(C, GTID, gsz, MA); }
    SEAM();
    pg8::PG8_LAS_T ring = (pg8::PG8_LAS_T)lds;
    for (int l = 0; l < DEPTH; ++l) {
        const bool last = l == DEPTH - 1; const int nrows = last ? ML : MA;
#ifndef SKIP_IN
        { const Ctx C = CTX(l); pg8::Gemm g{C.H, wts(C.p, l, W_IN), MA, 1536, D, D, 1 << 30, 0}; pg8::StaticOrder S; S.init(MA, 1536, ogrid(), obid()); EpiIn E{C}; pg8::gemm_phase<EpiIn, true>(ring, g, S, E, TID); }
#endif
        SEAM();
#ifndef SKIP_UP
        { const Ctx C = CTX(l); pg8::Gemm g{C.AUP(), wts(C.p, l, W_UP), MA, 1792, 256, 512, 3, 256}; pg8::StaticOrder S; S.init(MA, 1792, ogrid(), obid()); EpiUp E{C}; pg8::gemm_phase<EpiUp, true>(ring, g, S, E, TID); }
#endif
        SEAM();
#ifndef SKIP_ATT
#ifdef NAIVE_ATT
        { const Ctx C = CTX(l); nv::ph_attn(C, (float*)lds, !last); }
#else
        { const Ctx C = CTX(l); fa::ph_attn(C, (LAS unsigned char*)lds, TID, !last); }
#endif
#endif
        SEAM();
#ifndef SKIP_OUT
        { const Ctx C = CTX(l); pg8::Gemm g{C.Y(), wts(C.p, l, W_OUT), nrows, D, D, D, 1 << 30, 0}; pg8::StaticOrder S; S.init(nrows, D, ogrid(), obid()); EpiRes E{C, 2, true}; pg8::gemm_phase<EpiRes, true>(ring, g, S, E, TID); }
#endif
        SEAM();
        { const Ctx C = CTX(l); ph_ln(C, nrows, C.p.ln1_g + l * D, C.p.ln1_b + l * D, true, l, 3, nullptr); }
        SEAM();
#ifndef SKIP_FC1
        { const Ctx C = CTX(l); pg8::Gemm g{C.H, wts(C.p, l, W_FC1), nrows, DFF, D, D, 1 << 30, 0}; pg8::StaticOrder S; S.init(nrows, DFF, ogrid(), obid()); EpiRelu2 E{C.HID()}; pg8::gemm_phase<EpiRelu2, true>(ring, g, S, E, TID); }
#endif
        SEAM();
#ifndef SKIP_FC2
        { const Ctx C = CTX(l); pg8::Gemm g{C.HID(), wts(C.p, l, W_FC2), nrows, D, DFF, DFF, 1 << 30, 0}; pg8::StaticOrder S; S.init(nrows, D, ogrid(), obid()); EpiRes E{C, 5, false}; pg8::gemm_phase<EpiRes, true>(ring, g, S, E, TID); }
#endif
        SEAM();
        { const Ctx C = CTX(l); ph_ln(C, nrows, C.p.ln2_g + l * D, C.p.ln2_b + l * D, !last, l + 1, 0, nullptr); }
        if (!last) SEAM();
    }
    { const Ctx C = CTX(0); if (xb_ld((unsigned*)(C.p.ws + WS_CTL) + CW_BAR + XB_TMO) != 0u) { __syncthreads(); for (int i = GTID; i < ML * D; i += gsz) C.p.out[i] = __builtin_nanf(""); } }
#undef TID
#undef GTID
#undef CTX
#undef SEAM
}

extern "C" void kernel_launch(void* const* d_in, const int* in_sizes, int n_in, void* d_out, int out_size, void* d_ws, size_t ws_size, hipStream_t stream) {
    static int grid = 0;
    if (grid == 0) {
        if (n_in != 22 || out_size != ML * D || ws_size < WS_END) { fprintf(stderr, "kernel_launch: unexpected shapes n_in %d out %d ws %zu (need %zu)\n", n_in, out_size, ws_size, (size_t)WS_END); grid = -1; return; }
        int dev = 0, cus = 0, per_cu = 0;
        hipGetDevice(&dev); hipDeviceGetAttribute(&cus, hipDeviceAttributeMultiprocessorCount, dev);
        hipFuncSetAttribute((const void*)fwd_kernel, hipFuncAttributeMaxDynamicSharedMemorySize, LDS_BYTES);
        hipOccupancyMaxActiveBlocksPerMultiprocessor(&per_cu, (const void*)fwd_kernel, NTHREADS, LDS_BYTES);
        if (per_cu < 1) { fprintf(stderr, "kernel_launch: occupancy query says %d blocks per CU\n", per_cu); grid = -1; return; }
        grid = cus;
    }
    if (grid < 0) return;
    hipMemsetAsync((char*)d_ws + WS_CTL, 0, 1 * MiB, stream);
    Params p{};
    const float** pp = (const float**)&p;
    for (int i = 0; i < 22; ++i) pp[i] = (const float*)d_in[i];
    p.out = (float*)d_out; p.ws = (unsigned char*)d_ws;
    void* args[] = {&p};
    hipError_t e = hipLaunchCooperativeKernel((const void*)fwd_kernel, dim3(grid), dim3(NTHREADS), args, LDS_BYTES, stream);
    if (e != hipSuccess) fprintf(stderr, "cooperative launch failed: %s (grid %d)\n", hipGetErrorString(e), grid);
}
```

```cpp
#include <hip/hip_runtime.h>
#include <hip/hip_cooperative_groups.h>
#include <cstdio>
#include <cstdint>
namespace cg = cooperative_groups;

constexpr int D = 1024, NB = 2, SEQ = 8192, CTX = 256, DEPTH = 2;
constexpr int ML = NB * SEQ, MC = NB * CTX, MA = ML + MC;
constexpr int DIN = 1440, DFF = 4096, DMOD = 6 * D;
constexpr int KROWS = CTX + SEQ, NTILE = KROWS / 64;
constexpr float LN_EPS = 1e-6f, RMS_EPS = 1e-6f;
constexpr float ALPHA = 1.41421356237309515f;
constexpr float LOG2E = 1.4426950408889634f;
constexpr float C2AB = 0.125f * LOG2E;
constexpr float C2C = 0.10206207261596577f * LOG2E;
constexpr int NTHREADS = 512;

typedef unsigned short bf16;

constexpr size_t MiB = 1u << 20;
constexpr size_t al(size_t x) { return (x + 255) & ~(size_t)255; }
constexpr size_t WS_CTL = 0;
constexpr size_t WS_MOD = 1 * MiB;
constexpr size_t WS_T64 = WS_MOD + al((size_t)DEPTH * 3 * DMOD * 4);
constexpr size_t WS_T32 = WS_T64 + al(128 * 16 * 8);
constexpr size_t WS_SSQ = WS_T32 + al(128 * 8 * 8);
constexpr size_t WS_RC = WS_SSQ + al((size_t)MA * 8 * 4);
constexpr size_t WS_H = WS_RC + al((size_t)MC * D * 4);
constexpr size_t WS_W = WS_H + al((size_t)MA * D * 2);
constexpr size_t W_IN = 0, W_UP = W_IN + (size_t)1536 * 1024 * 2, W_OUT = W_UP + (size_t)1792 * 256 * 2,
                 W_FC1 = W_OUT + (size_t)1024 * 1024 * 2, W_FC2 = W_FC1 + (size_t)4096 * 1024 * 2, W_LAYER = W_FC2 + (size_t)4096 * 1024 * 2;
constexpr size_t WS_R = WS_W + al(DEPTH * W_LAYER);
constexpr size_t R_QA = 0, R_QB = R_QA + (size_t)MA * 256 * 2, R_QC = R_QB + (size_t)MA * 256 * 2, R_AUP = R_QC + (size_t)MA * 768 * 2,
                 R_KA = R_AUP + (size_t)MA * 512 * 2, IMG64 = (size_t)NTILE * 4096 * 2  ,
                 R_VA = R_KA + 4 * IMG64, R_KB = R_VA + 4 * IMG64, R_VB = R_KB + 4 * IMG64, R_KC = R_VB + 4 * IMG64, R_VC = R_KC + 16 * IMG64,
                 R_KR = R_VC + 16 * IMG64, R_Y = R_KR + 2 * IMG64 / 2, R_END = R_Y + (size_t)MA * D * 2;
constexpr size_t R_HID = 0;
static_assert((size_t)MA * DFF * 2 <= R_END, "hid overlay");
constexpr size_t WS_END = WS_R + R_END;
static_assert(WS_END <= 256 * MiB, "workspace");

struct Params {
    const float *x, *c, *ctx, *c_ctx, *w_mod, *b_mod, *w_in, *sink_a, *q_norm_b, *k_norm_b, *mla_q_norm, *mla_kv_norm,
        *w_uq, *w_uk, *w_uv, *w_out, *ln1_g, *ln1_b, *w_fc1, *w_fc2, *ln2_g, *ln2_b;
    float* out; unsigned char* ws;
};

__device__ __forceinline__ unsigned f2bf(float f) { unsigned u = __builtin_bit_cast(unsigned, f); return (u + 0x7fffu + ((u >> 16) & 1u)) >> 16; }
__device__ __forceinline__ int otid(int wave) {
    int l; asm volatile("v_mbcnt_lo_u32_b32 %0, -1, 0\n\tv_mbcnt_hi_u32_b32 %0, -1, %0" : "=v"(l)); return wave * 64 + l; }
__device__ __forceinline__ int obid() { int b = blockIdx.x; asm volatile("" : "+s"(b)); return b; }
__device__ __forceinline__ int ogrid() { int g = gridDim.x; asm volatile("" : "+s"(g)); return g; }
__device__ __forceinline__ float bf2f(unsigned h) { return __builtin_bit_cast(float, h << 16); }
__device__ __forceinline__ void swap32(float v, float& lo, float& hi) {
    float a = v, b;
    asm volatile("v_mov_b32_e32 %1, %0\n\ts_nop 1\n\tv_permlane32_swap_b32_e32 %0, %1" : "+v"(a), "=&v"(b));
    lo = a; hi = b;
}
__device__ __forceinline__ float wave_sum(float v) {
#define WS_STEP(m) v += __builtin_bit_cast(float, __builtin_amdgcn_ds_swizzle(__builtin_bit_cast(int, v), (m)))
    WS_STEP(0x041f); WS_STEP(0x081f); WS_STEP(0x101f); WS_STEP(0x201f); WS_STEP(0x401f);
#undef WS_STEP
    float lo, hi; swap32(v, lo, hi); return lo + hi;
}
__device__ __forceinline__ size_t kimg(int krow, int d) { return ((size_t)((krow >> 6) * 8 + (d >> 3)) * 64 + (krow & 63)) * 8 + (d & 7); }
__device__ __forceinline__ size_t krimg(int krow, int d) { return ((size_t)((krow >> 6) * 4 + (d >> 3)) * 64 + (krow & 63)) * 8 + (d & 7); }
__device__ __forceinline__ size_t vimg(int krow, int d) { const int rr = krow & 63; return (size_t)(krow >> 6) * 4096 + (d >> 5) * 2048 + (rr >> 4) * 512 + (rr & 15) * 32 + (d & 31); }
struct RowInfo { int b, krow, set, t; bool lat; };
__device__ __forceinline__ RowInfo row_info(int r) {
    RowInfo ri;
    if (r < ML) { ri.b = r >> 13; ri.t = r & (SEQ - 1); ri.krow = CTX + ri.t; ri.set = ri.b; ri.lat = true; }
    else { const int j = r - ML; ri.b = j >> 8; ri.t = 0; ri.krow = j & 255; ri.set = 2; ri.lat = false; }
    return ri;
}
struct Ctx {
    Params p; int layer, wave;
    __device__ __forceinline__ int tid() const { return otid(wave); }
    float* MOD; float2* T64; float2* T32; float* SSQ; float* RC; bf16* H; unsigned char* R;
    __device__ __forceinline__ const float* mod(int set, int which) const { return MOD + ((size_t)(layer * 3 + set) * 6 + which) * D; }
    __device__ __forceinline__ const float* resid_in(int r) const {
        if (layer == 0) return r < ML ? p.x + (size_t)r * D : p.ctx + (size_t)(r - ML) * D;
        return r < ML ? p.out + (size_t)r * D : RC + (size_t)(r - ML) * D; }
    __device__ __forceinline__ float* resid(int r) const { return r < ML ? p.out + (size_t)r * D : RC + (size_t)(r - ML) * D; }
    __device__ __forceinline__ bf16* QA() const { return (bf16*)(R + R_QA); }
    __device__ __forceinline__ bf16* QB() const { return (bf16*)(R + R_QB); }
    __device__ __forceinline__ bf16* QC() const { return (bf16*)(R + R_QC); }
    __device__ __forceinline__ bf16* AUP() const { return (bf16*)(R + R_AUP); }
    __device__ __forceinline__ bf16* KA(int b, int kv) const { return (bf16*)(R + R_KA + (size_t)(b * 2 + kv) * IMG64); }
    __device__ __forceinline__ bf16* VA(int b, int kv) const { return (bf16*)(R + R_VA + (size_t)(b * 2 + kv) * IMG64); }
    __device__ __forceinline__ bf16* KB(int b, int kv) const { return (bf16*)(R + R_KB + (size_t)(b * 2 + kv) * IMG64); }
    __device__ __forceinline__ bf16* VB(int b, int kv) const { return (bf16*)(R + R_VB + (size_t)(b * 2 + kv) * IMG64); }
    __device__ __forceinline__ bf16* KC(int b, int h) const { return (bf16*)(R + R_KC + (size_t)(b * 8 + h) * IMG64); }
    __device__ __forceinline__ bf16* VC(int b, int h) const { return (bf16*)(R + R_VC + (size_t)(b * 8 + h) * IMG64); }
    __device__ __forceinline__ bf16* KR(int b) const { return (bf16*)(R + R_KR + (size_t)b * (IMG64 / 2)); }
    __device__ __forceinline__ bf16* Y() const { return (bf16*)(R + R_Y); }
    __device__ __forceinline__ bf16* HID() const { return (bf16*)(R + R_HID); }
};

namespace nv {
__device__ __forceinline__ float silu(float v) { return v / (1.f + expf(-v)); }

__device__ __forceinline__ void ph_mod_tables(const Ctx& C, int gtid, int gsz) {
    for (int idx = gtid; idx < DEPTH * 3 * DMOD; idx += gsz) {
        const int l = idx / (3 * DMOD), s = (idx / DMOD) % 3, n = idx % DMOD;
        const float* cv = s < 2 ? C.p.c + s * D : C.p.c_ctx;
        const float* w = C.p.w_mod + (size_t)l * D * DMOD + n;
        float acc = C.p.b_mod[l * DMOD + n];
        for (int k = 0; k < D; ++k) acc += silu(cv[k]) * w[(size_t)k * DMOD];
        C.MOD[idx] = acc;
    }
    for (int idx = gtid; idx < 128 * 16; idx += gsz) { const int pos = idx >> 4, j = idx & 15; const float inv = powf(10000.f, -(float)j / 16.f), a = (float)pos * inv; C.T64[idx] = make_float2(cosf(a), sinf(a)); }
    for (int idx = gtid; idx < 128 * 8; idx += gsz) { const int pos = idx >> 3, j = idx & 7; const float inv = powf(10000.f, -(float)j / 8.f), a = (float)pos * inv; C.T32[idx] = make_float2(cosf(a), sinf(a)); }
}
__device__ __forceinline__ void ph_modulate(const Ctx& C, int gtid, int gsz, int nrows) {
    for (size_t idx = gtid; idx < (size_t)nrows * (D / 4); idx += gsz) {
        const int r = (int)(idx / (D / 4)), c4 = (int)(idx % (D / 4)) * 4; const RowInfo ri = row_info(r);
        const float4 v = *(const float4*)(C.resid_in(r) + c4); const float4 sc = *(const float4*)(C.mod(ri.set, 1) + c4), sh = *(const float4*)(C.mod(ri.set, 0) + c4);
        ushort4 o; o.x = f2bf(v.x * (1.f + sc.x) + sh.x); o.y = f2bf(v.y * (1.f + sc.y) + sh.y); o.z = f2bf(v.z * (1.f + sc.z) + sh.z); o.w = f2bf(v.w * (1.f + sc.w) + sh.w);
        *(ushort4*)(C.H + (size_t)r * D + c4) = o;
    }
}
__device__ __forceinline__ void rope64(float* v, int t, const float2* T64) {
#pragma unroll
    for (int i = 0; i < 32; ++i) { const int pos = i < 16 ? (t >> 6) : (t & 63); const float2 cs = T64[pos * 16 + (i & 15)]; const float x1 = v[i], x2 = v[i + 32]; v[i] = x1 * cs.x - x2 * cs.y; v[i + 32] = x1 * cs.y + x2 * cs.x; }
}
__device__ __forceinline__ void rope32(float* v, int t, const float2* T32) {
#pragma unroll
    for (int i = 0; i < 16; ++i) { const int pos = i < 8 ? (t >> 6) : (t & 63); const float2 cs = T32[pos * 8 + (i & 7)]; const float x1 = v[i], x2 = v[i + 16]; v[i] = x1 * cs.x - x2 * cs.y; v[i + 16] = x1 * cs.y + x2 * cs.x; }
}
template <int NJ> __device__ __forceinline__ void dotrow(float* acc, const bf16* a, const float* w, int K, int ldw, const float* kscale) {
    for (int k = 0; k < K; ++k) { float av = bf2f(a[k]); if (kscale) av *= kscale[k]; const float* wr = w + (size_t)k * ldw;
#pragma unroll
        for (int j = 0; j < NJ; ++j) acc[j] += av * wr[j]; }
}
__device__ __forceinline__ void ph_in(const Ctx& C, int gtid, int gsz) {
    const int l = C.layer; const float* W = C.p.w_in + (size_t)l * D * DIN;
    for (int task = gtid; task < 23 * MA; task += gsz) {
        const int slot = __builtin_amdgcn_readfirstlane(task / MA), r = task % MA; const RowInfo ri = row_info(r);
        float acc[64];
#pragma unroll
        for (int j = 0; j < 64; ++j) acc[j] = 0.f;
        const bf16* a = C.H + (size_t)r * D;
        if (slot < 22) dotrow<64>(acc, a, W + slot * 64, D, DIN, nullptr); else dotrow<32>(acc, a, W + 1408, D, DIN, nullptr);
        if (slot < 16) {
            const int grp = slot >> 2 & 1 ? 1 : 0;
            const bool isB = slot >= 8; const int s8 = slot & 7;
            const bool isq = s8 < 4, isk = s8 == 4 || s8 == 5; (void)grp;
            if (isB && (isq || isk)) { float ss = 0.f;
#pragma unroll
                for (int j = 0; j < 64; ++j) ss += acc[j] * acc[j];
                const float rs = rsqrtf(ss * (1.f / 64.f) + RMS_EPS); const float* g = (isq ? C.p.q_norm_b : C.p.k_norm_b) + l * 64;
#pragma unroll
                for (int j = 0; j < 64; ++j) acc[j] = acc[j] * rs * g[j]; }
            if ((isq || isk) && ri.lat) rope64(acc, ri.t, C.T64);
            if (isq) { bf16* q = (isB ? C.QB() : C.QA()) + (size_t)r * 256 + s8 * 64;
#pragma unroll
                for (int j = 0; j < 64; ++j) q[j] = f2bf(acc[j] * C2AB); }
            else if (isk) { bf16* k = isB ? C.KB(ri.b, s8 - 4) : C.KA(ri.b, s8 - 4);
#pragma unroll
                for (int j = 0; j < 64; ++j) k[kimg(ri.krow, j)] = f2bf(acc[j]); }
            else { bf16* v = isB ? C.VB(ri.b, s8 - 6) : C.VA(ri.b, s8 - 6);
#pragma unroll
                for (int j = 0; j < 64; ++j) v[vimg(ri.krow, j)] = f2bf(acc[j]); }
        } else if (slot < 22) {
            const int p = slot - 16; float ss = 0.f; bf16* o = C.AUP() + (size_t)r * 512 + p * 64;
#pragma unroll
            for (int j = 0; j < 64; ++j) { ss += acc[j] * acc[j]; o[j] = f2bf(acc[j]); }
            C.SSQ[(size_t)r * 8 + p] = ss;
            if (p >= 4) { C.SSQ[(size_t)r * 8 + p + 2] = 0.f;
#pragma unroll
                for (int j = 0; j < 64; ++j) o[128 + j] = 0; }
        } else {
            if (ri.lat) rope32(acc, ri.t, C.T32);
            bf16* k = C.KR(ri.b);
#pragma unroll
            for (int j = 0; j < 32; ++j) k[krimg(ri.krow, j)] = f2bf(acc[j]);
        }
    }
}
__device__ __forceinline__ void ph_up(const Ctx& C, int gtid, int gsz) {
    const int l = C.layer;
    for (int task = gtid; task < 24 * MA; task += gsz) {
        const int g = __builtin_amdgcn_readfirstlane(task / MA), r = task % MA; const RowInfo ri = row_info(r);
        const float* sq = C.SSQ + (size_t)r * 8;
        float acc[96];
#pragma unroll
        for (int j = 0; j < 96; ++j) acc[j] = 0.f;
        if (g < 8) {
            const float rs = rsqrtf((sq[0] + sq[1] + sq[2] + sq[3]) * (1.f / 256.f) + RMS_EPS);
            dotrow<96>(acc, C.AUP() + (size_t)r * 512, C.p.w_uq + (size_t)l * 256 * 768 + g * 96, 256, 768, C.p.mla_q_norm + l * 256);
#pragma unroll
            for (int j = 0; j < 96; ++j) acc[j] *= rs;
            if (ri.lat) rope32(acc + 64, ri.t, C.T32);
            bf16* q = C.QC() + (size_t)r * 768 + g * 96;
#pragma unroll
            for (int j = 0; j < 96; ++j) q[j] = f2bf(acc[j] * C2C);
        } else {
            const float rs = rsqrtf((sq[4] + sq[5] + sq[6] + sq[7]) * (1.f / 128.f) + RMS_EPS); const int h = g & 7; const bool isk = g < 16;
            dotrow<64>(acc, C.AUP() + (size_t)r * 512 + 256, (isk ? C.p.w_uk : C.p.w_uv) + (size_t)l * 128 * 512 + h * 64, 128, 512, C.p.mla_kv_norm + l * 128);
            bf16* o = isk ? C.KC(ri.b, h) : C.VC(ri.b, h);
#pragma unroll
            for (int j = 0; j < 64; ++j) o[isk ? kimg(ri.krow, j) : vimg(ri.krow, j)] = f2bf(acc[j] * rs);
        }
    }
}
template <int DQK> __device__ __forceinline__ void attn_unit(const Ctx& C, float* lds, int type  , int b, int h, int row0, int nq, bool lat) {
    float* Ks = lds; float* Vs = lds + 64 * DQK;
    const int tid = C.tid(); const bool act = tid < nq; const int r = row0 + (act ? tid : 0);
    const int kvh = type == 2 ? h : (h >> 1);
    const bf16* Kimg = type == 0 ? C.KA(b, kvh) : type == 1 ? C.KB(b, kvh) : C.KC(b, kvh);
    const bf16* Vimg = type == 0 ? C.VA(b, kvh) : type == 1 ? C.VB(b, kvh) : C.VC(b, kvh);
    const bf16* Q = type == 0 ? C.QA() + (size_t)r * 256 + h * 64 : type == 1 ? C.QB() + (size_t)r * 256 + h * 64 : C.QC() + (size_t)r * 768 + h * 96;
    float q[DQK], o[64];
#pragma unroll
    for (int j = 0; j < DQK; ++j) q[j] = bf2f(Q[j]);
#pragma unroll
    for (int j = 0; j < 64; ++j) o[j] = 0.f;
    float m = -1e30f, lsum = 0.f;
    const int qpos = lat ? (r & (SEQ - 1)) : 0;
    int tlo = 4, thi = lat ? NTILE : 4;
    if (type == 0 && lat) { const int p0 = (row0 & (SEQ - 1)); int lo = p0 - 128, hi = p0 + nq + 128; if (lo < 0) lo = 0; if (hi > SEQ) hi = SEQ; tlo = 4 + lo / 64; thi = 4 + hi / 64; }
    for (int pass = 0; pass < 2; ++pass) {
        const int ta = pass == 0 ? 0 : tlo, tb = pass == 0 ? 4 : thi;
        for (int t = ta; t < tb; ++t) {
            __syncthreads();
            for (int e = tid; e < 64 * DQK; e += NTHREADS) { const int key = e / DQK, d = e % DQK;
                Ks[e] = d < 64 ? bf2f(Kimg[kimg(t * 64 + key, d)]) : bf2f(C.KR(b)[krimg(t * 64 + key, d - 64)]); }
            for (int e = tid; e < 64 * 64; e += NTHREADS) { const int key = e >> 6, d = e & 63; Vs[e] = bf2f(Vimg[vimg(t * 64 + key, d)]); }
            __syncthreads();
            for (int key = 0; key < 64; ++key) {
                float s = 0.f;
#pragma unroll
                for (int j = 0; j < DQK; ++j) s += q[j] * Ks[key * DQK + j];
                if (type == 0 && t >= 4) { const int kpos = (t - 4) * 64 + key; const int rel = kpos - qpos; if (rel > 128 || rel < -128) s = -1e30f; }
                if (s > m) { const float f = exp2f(m - s); lsum *= f;
#pragma unroll
                    for (int j = 0; j < 64; ++j) o[j] *= f;
                    m = s; }
                const float pr = exp2f(s - m); lsum += pr;
#pragma unroll
                for (int j = 0; j < 64; ++j) o[j] += pr * Vs[key * 64 + j];
            }
        }
    }
    if (type == 0) lsum += exp2f(C.p.sink_a[C.layer * 4 + h] * LOG2E - m);
    if (act) { const float inv = 1.f / lsum; bf16* y = C.Y() + (size_t)r * D + (type == 0 ? 0 : type == 1 ? 256 : 512) + h * 64;
#pragma unroll
        for (int j = 0; j < 64; ++j) y[j] = f2bf(o[j] * inv); }
}
__device__ __forceinline__ void ph_attn(const Ctx& C, float* lds, bool with_ctx) {
    const int nlat = 128 + 128 + 256, nctx = with_ctx ? 32 : 0;
    for (int u = obid(); u < nlat + nctx; u += ogrid()) {
        if (u < nlat) {
            int type, idx; if (u < 128) { type = 0; idx = u; } else if (u < 256) { type = 1; idx = u - 128; } else { type = 2; idx = u - 256; }
            const int nh = type == 2 ? 8 : 4; const int qb = idx & 15, h = (idx >> 4) % nh, b = (idx >> 4) / nh;
            if (type == 2) attn_unit<96>(C, lds, type, b, h, b * SEQ + qb * 512, 512, true); else attn_unit<64>(C, lds, type, b, h, b * SEQ + qb * 512, 512, true);
        } else {
            const int v = u - nlat; int type, idx; if (v < 8) { type = 0; idx = v; } else if (v < 16) { type = 1; idx = v - 8; } else { type = 2; idx = v - 16; }
            const int nh = type == 2 ? 8 : 4; const int h = idx % nh, b = idx / nh;
            if (type == 2) attn_unit<96>(C, lds, type, b, h, ML + b * CTX, 256, false); else attn_unit<64>(C, lds, type, b, h, ML + b * CTX, 256, false);
        }
    }
}
__device__ __forceinline__ void ph_proj_res(const Ctx& C, int gtid, int gsz, const bf16* A, int K, const float* W  , int which_gate, int nrows, bool first) {
    for (int task = gtid; task < 16 * nrows; task += gsz) {
        const int cgp = __builtin_amdgcn_readfirstlane(task / nrows), r = task % nrows; const RowInfo ri = row_info(r);
        float acc[64];
#pragma unroll
        for (int j = 0; j < 64; ++j) acc[j] = 0.f;
        dotrow<64>(acc, A + (size_t)r * K, W + cgp * 64, K, D, nullptr);
        const float* base = first ? C.resid_in(r) : C.resid(r); float* o = C.resid(r); const float* g = C.mod(ri.set, which_gate);
#pragma unroll
        for (int j = 0; j < 64; ++j) { const int c = cgp * 64 + j; o[c] = ALPHA * base[c] + g[c] * acc[j]; }
    }
}
__device__ __forceinline__ void ph_fc1(const Ctx& C, int gtid, int gsz, int nrows) {
    const float* W = C.p.w_fc1 + (size_t)C.layer * D * DFF;
    for (int task = gtid; task < 64 * nrows; task += gsz) {
        const int cgp = __builtin_amdgcn_readfirstlane(task / nrows), r = task % nrows;
        float acc[64];
#pragma unroll
        for (int j = 0; j < 64; ++j) acc[j] = 0.f;
        dotrow<64>(acc, C.H + (size_t)r * D, W + cgp * 64, D, DFF, nullptr);
        bf16* o = C.HID() + (size_t)r * DFF + cgp * 64;
#pragma unroll
        for (int j = 0; j < 64; ++j) { const float a = fmaxf(acc[j], 0.f); o[j] = f2bf(a * a); }
    }
}
}

__device__ __forceinline__ void ph_ln(const Ctx& C, int nrows, const float* g, const float* bta, bool make_h, int mlayer, int which_sh, float* final_out_unused) {
    const int tid_ = C.tid(); const int lane = tid_ & 63, gw = obid() * (NTHREADS / 64) + (tid_ >> 6), ngw = ogrid() * (NTHREADS / 64);
    for (int r = gw; r < nrows; r += ngw) {
        float* xr = C.resid(r); const RowInfo ri = row_info(r);
        float4 v[4]; float s = 0.f;
#pragma unroll
        for (int j = 0; j < 4; ++j) { v[j] = *(const float4*)(xr + 4 * lane + 256 * j); s += (v[j].x + v[j].y) + (v[j].z + v[j].w); }
        const float mean = wave_sum(s) * (1.f / D); float s2 = 0.f;
#pragma unroll
        for (int j = 0; j < 4; ++j) { v[j].x -= mean; v[j].y -= mean; v[j].z -= mean; v[j].w -= mean; s2 += (v[j].x * v[j].x + v[j].y * v[j].y) + (v[j].z * v[j].z + v[j].w * v[j].w); }
        const float rstd = rsqrtf(wave_sum(s2) * (1.f / D) + LN_EPS);
        const float* sc = C.MOD + ((size_t)(mlayer * 3 + ri.set) * 6 + which_sh + 1) * D; const float* sh = C.MOD + ((size_t)(mlayer * 3 + ri.set) * 6 + which_sh) * D;
#pragma unroll
        for (int j = 0; j < 4; ++j) { const int c = 4 * lane + 256 * j; const float4 gg = *(const float4*)(g + c), bb = *(const float4*)(bta + c);
            float4 y; y.x = v[j].x * rstd * gg.x + bb.x; y.y = v[j].y * rstd * gg.y + bb.y; y.z = v[j].z * rstd * gg.z + bb.z; y.w = v[j].w * rstd * gg.w + bb.w;
            *(float4*)(xr + c) = y;
            if (make_h) { const float4 a = *(const float4*)(sc + c), d = *(const float4*)(sh + c); ushort4 o;
                o.x = f2bf(y.x * (1.f + a.x) + d.x); o.y = f2bf(y.y * (1.f + a.y) + d.y); o.z = f2bf(y.z * (1.f + a.z) + d.z); o.w = f2bf(y.w * (1.f + a.w) + d.w);
                *(ushort4*)(C.H + (size_t)r * D + c) = o; } }
    }
}


namespace pg8 {
#define PG8_LAS __attribute__((address_space(3)))
typedef PG8_LAS unsigned char* PG8_LAS_T;
typedef unsigned short bf16_t;
typedef short bf16x8 __attribute__((ext_vector_type(8)));
typedef float f32x4 __attribute__((ext_vector_type(4)));
typedef unsigned u32x4 __attribute__((ext_vector_type(4)));
typedef unsigned u32x2 __attribute__((ext_vector_type(2)));
constexpr int BM = 256, BK = 64, HALF = 128, HTB = HALF * BK * 2, STAGE_BYTES = 8 * HTB, NXCD = 8, WGM = 8;
__host__ __device__ __forceinline__ int lds_byte(int r, int c) { const int st = (r >> 4) * 2 + (c >> 5), rr = r & 15, cc = c & 31, ob = rr * 64 + cc * 2; return st * 1024 + (ob ^ (((ob >> 9) & 1) << 5)); }
__host__ __device__ __forceinline__ void stage_rc(int b, int& R, int& C) { const int st = b / 1024, sb = b % 1024, swz = sb ^ (((sb >> 9) & 1) << 5); R = (st >> 1) * 16 + swz / 64; C = (st & 1) * 32 + (swz % 64) / 2; }
__host__ __device__ __forceinline__ int perm32(int rho) { const int n = rho >> 4, i = rho & 15; return 8 * (i >> 2) + 4 * n + (i & 3); }
struct Unit { int pm, pn; };
struct Gemm { const bf16_t* A; const bf16_t* Bt; int M, N, K, lda, asplit, akoff; };
struct StaticOrder {
    int nM, nN, nwg, G, c;
    __host__ __device__ void init(int M, int N, int G_, int c_) { nM = M / BM; nN = N / BM; nwg = nM * nN; G = G_; c = c_; }
    __host__ __device__ bool next(int i, Unit& u) const {
        const long L = (long)i * G + c; if (L >= nwg) return false;
        int wgid = (int)L; { const int q = nwg / NXCD, r = nwg % NXCD, xcd = wgid % NXCD, off = wgid / NXCD; wgid = (xcd < r ? xcd * (q + 1) : r * (q + 1) + (xcd - r) * q) + off; }
        const int nig = WGM * nN, gid = wgid / nig, fm = gid * WGM, gsz = (nM - fm) < WGM ? (nM - fm) : WGM;
        u.pm = fm + ((wgid % nig) % gsz); u.pn = (wgid % nig) / gsz; return true;
    }
};
__device__ __forceinline__ unsigned cvt_pk_bf16(float lo, float hi) { unsigned r; asm volatile("v_cvt_pk_bf16_f32 %0, %1, %2" : "=v"(r) : "v"(lo), "v"(hi)); return r; }
__device__ __forceinline__ u32x4 pack8(const f32x4& a, const f32x4& b) { u32x4 w; w.x = cvt_pk_bf16(a[0], a[1]); w.y = cvt_pk_bf16(a[2], a[3]); w.z = cvt_pk_bf16(b[0], b[1]); w.w = cvt_pk_bf16(b[2], b[3]); return w; }

template <class Epi, bool ALIGN_EPI>
__device__ __forceinline__ void gemm_phase(PG8_LAS unsigned char* lds, const Gemm g, const StaticOrder& S, const Epi& E, const int tid) {
    const int wid = __builtin_amdgcn_readfirstlane(tid >> 6), lane = tid & 63, wr = wid >> 2, wc = wid & 3, fr = lane & 15, fq = lane >> 4;
    const int K = g.K, nt = K / BK, lda = g.lda;
    unsigned voffA[2], voffB[2];
#pragma unroll
    for (int i = 0; i < 2; ++i) { int R, C; stage_rc(tid * 16 + i * 8192, R, C); const int Rb = Epi::PERM ? ((R & ~31) + perm32(R & 31)) : R;
        voffA[i] = (unsigned)(R * lda + C) * 2u; voffB[i] = (unsigned)(Rb * K + C) * 2u; }
    const size_t kstep = (size_t)(BK * 2);
    const size_t hstepA = (size_t)HALF * lda * 2, tstepA = 2 * hstepA;
    const size_t hstepB = (size_t)HALF * K * 2, tstepB = 2 * hstepB;
    const unsigned ldsw = (unsigned)wid * 1024u;
    const int aoff = lds_byte(wr * 64 + fr, fq * 8), boff = lds_byte(wc * 32 + fr, fq * 8);
#define PG8_SA(b, h) (((b) * 2 + (h)) * HTB)
#define PG8_SB(b, h) ((4 + (b) * 2 + (h)) * HTB)
#define PG8_STAGE(bufoff, gbase, voff) do { _Pragma("unroll") for (int _i = 0; _i < 2; ++_i) \
        __builtin_amdgcn_global_load_lds((const unsigned*)((const char*)(gbase) + (voff)[_i]), (PG8_LAS unsigned*)(lds + (bufoff) + ldsw + _i * 8192), 16, 0, 0); } while (0)
#define PG8_LDA(dst, b, h) do { _Pragma("unroll") for (int m = 0; m < 4; ++m) _Pragma("unroll") for (int k = 0; k < 2; ++k) dst[m][k] = *(const PG8_LAS bf16x8*)(lds + PG8_SA(b, h) + aoff + m * 2048 + k * 1024); } while (0)
#define PG8_LDB(dst, b, h) do { _Pragma("unroll") for (int n = 0; n < 2; ++n) _Pragma("unroll") for (int k = 0; k < 2; ++k) dst[n][k] = *(const PG8_LAS bf16x8*)(lds + PG8_SB(b, h) + boff + n * 2048 + k * 1024); } while (0)
#define PG8_MMA(ai, bj, At, Bt) do { __builtin_amdgcn_s_setprio(1); _Pragma("unroll") for (int m = 0; m < 4; ++m) _Pragma("unroll") for (int n = 0; n < 2; ++n) _Pragma("unroll") for (int k = 0; k < 2; ++k) \
        acc[ai][bj][m][n] = __builtin_amdgcn_mfma_f32_16x16x32_bf16(Bt[n][k], At[m][k], acc[ai][bj][m][n], 0, 0, 0); __builtin_amdgcn_s_setprio(0); } while (0)
#define PG8_WAIT_V(n) asm volatile("s_waitcnt vmcnt(" #n ")" ::: "memory")
#define PG8_WAIT_L(n) asm volatile("s_waitcnt lgkmcnt(" #n ")" ::: "memory")
#define PG8_BAR __builtin_amdgcn_s_barrier()
#define PG8_SCHED __builtin_amdgcn_sched_barrier(0)
#define PG8_APTR(u) ((const char*)g.A + (size_t)(u).pm * tstepA + ((u).pn >= g.asplit ? (size_t)g.akoff * 2 : (size_t)0))
    Unit cur, nxt; int ui = 0;
    if (!S.next(0, cur)) return;
    f32x4 acc[2][2][4][2];
#pragma unroll
    for (int a = 0; a < 2; ++a)
#pragma unroll
        for (int b = 0; b < 2; ++b)
#pragma unroll
            for (int m = 0; m < 4; ++m)
#pragma unroll
                for (int n = 0; n < 2; ++n) acc[a][b][m][n] = (f32x4){0.f, 0.f, 0.f, 0.f};
    bf16x8 At[4][2], B0[2][2], B1[2][2];
    const char* cA = PG8_APTR(cur); const char* cB = (const char*)g.Bt + (size_t)cur.pn * tstepB;
    {
        PG8_STAGE(PG8_SB(0, 0), cB, voffB); PG8_STAGE(PG8_SB(0, 1), cB + hstepB, voffB); PG8_STAGE(PG8_SA(0, 0), cA, voffA); PG8_STAGE(PG8_SA(0, 1), cA + hstepA, voffA);
        if (wr == 1) PG8_BAR;
        PG8_WAIT_V(2); PG8_BAR;
        PG8_STAGE(PG8_SB(1, 0), cB + kstep, voffB); PG8_STAGE(PG8_SA(1, 0), cA + kstep, voffA); PG8_STAGE(PG8_SB(1, 1), cB + hstepB + kstep, voffB);
        PG8_WAIT_V(6); PG8_BAR;
    }
    for (;;) {
        const bool has_next = S.next(ui + 1, nxt);
        const char* nA = has_next ? PG8_APTR(nxt) : cA; const char* nB = has_next ? (const char*)g.Bt + (size_t)nxt.pn * tstepB : cB;
        for (int t = 0; t < nt; t += 2) {
            const bool last = (t == nt - 2);
            const char* a1 = cA + (size_t)(t + 1) * kstep;
            const char* a2 = last ? nA : cA + (size_t)(t + 2) * kstep; const char* b2 = last ? nB : cB + (size_t)(t + 2) * kstep;
            const char* a3 = a2 + kstep; const char* b3 = b2 + kstep;
            PG8_LDB(B0, 0, 0); PG8_LDB(B1, 0, 1); PG8_SCHED; PG8_LDA(At, 0, 0); PG8_STAGE(PG8_SA(1, 1), a1 + hstepA, voffA);
            PG8_WAIT_V(8); PG8_WAIT_L(0); PG8_BAR; PG8_MMA(0, 0, At, B0); PG8_MMA(0, 1, At, B1); PG8_BAR; PG8_SCHED;
            PG8_LDA(At, 0, 1); PG8_STAGE(PG8_SB(0, 0), b2, voffB); PG8_STAGE(PG8_SB(0, 1), b2 + hstepB, voffB); PG8_STAGE(PG8_SA(0, 0), a2, voffA);
            PG8_WAIT_V(8); PG8_WAIT_L(0); PG8_BAR; PG8_MMA(1, 0, At, B0); PG8_MMA(1, 1, At, B1); PG8_BAR; PG8_SCHED;
            PG8_LDB(B0, 1, 0); PG8_LDB(B1, 1, 1); PG8_SCHED; PG8_LDA(At, 1, 0); PG8_STAGE(PG8_SA(0, 1), a2 + hstepA, voffA);
            PG8_WAIT_V(8); PG8_WAIT_L(0); PG8_BAR; PG8_MMA(0, 0, At, B0); PG8_MMA(0, 1, At, B1); PG8_BAR; PG8_SCHED;
            PG8_LDA(At, 1, 1); PG8_STAGE(PG8_SB(1, 0), b3, voffB); PG8_STAGE(PG8_SB(1, 1), b3 + hstepB, voffB); PG8_STAGE(PG8_SA(1, 0), a3, voffA);
            PG8_WAIT_V(8); PG8_WAIT_L(0); PG8_BAR; PG8_MMA(1, 0, At, B0); PG8_MMA(1, 1, At, B1); PG8_BAR; PG8_SCHED;
        }
        if constexpr (ALIGN_EPI) { if (wr == 0) PG8_BAR; }
        { int fr_ = fr, fq_ = fq; asm volatile("" : "+v"(fr_), "+v"(fq_)); E(acc, cur, wr, wc, fr_, fq_); }
        if (!has_next) break;
#pragma unroll
        for (int a = 0; a < 2; ++a)
#pragma unroll
            for (int b = 0; b < 2; ++b)
#pragma unroll
                for (int m = 0; m < 4; ++m)
#pragma unroll
                    for (int n = 0; n < 2; ++n) acc[a][b][m][n] = (f32x4){0.f, 0.f, 0.f, 0.f};
        cur = nxt; cA = nA; cB = nB; ++ui;
        if constexpr (ALIGN_EPI) { if (wr == 1) PG8_BAR; }
    }
    PG8_WAIT_V(0);
    if constexpr (!ALIGN_EPI) { if (wr == 0) PG8_BAR; }
    PG8_BAR;
#undef PG8_SA
#undef PG8_SB
#undef PG8_STAGE
#undef PG8_LDA
#undef PG8_LDB
#undef PG8_MMA
#undef PG8_WAIT_V
#undef PG8_WAIT_L
#undef PG8_BAR
#undef PG8_SCHED
#undef PG8_APTR
}
}

using pg8::f32x4; using pg8::u32x4; using pg8::u32x2;
typedef f32x4 AccT[2][2][4][2];
__device__ __forceinline__ float fq_sum(float v) {
    v += __builtin_bit_cast(float, __builtin_amdgcn_ds_swizzle(__builtin_bit_cast(int, v), 0x401f));
    float lo, hi; swap32(v, lo, hi); return lo + hi;
}
__device__ __forceinline__ void st16(bf16* p, u32x4 v) { *(u32x4*)p = v; }

struct EpiIn {
    static constexpr bool PERM = true;
    Ctx C;
    __device__ __forceinline__ void operator()(const AccT& acc, const pg8::Unit& u, int wr, int wc, int fr, int fq) const {
        const int tile = u.pn; const bool lat = u.pm < ML / 256; const int l = C.layer;
        if (tile < 4) {
            const bool isB = tile >= 2, qt = (tile & 1) == 0; const bool isq = qt, isk = !qt && wc < 2;
            const int hh = qt ? wc : (wc & 1);
            f32x4 gn[2][2];
            if (isB && !(!isq && !isk)) { const float* g = (isq ? C.p.q_norm_b : C.p.k_norm_b) + l * 64;
#pragma unroll
                for (int bj = 0; bj < 2; ++bj)
#pragma unroll
                    for (int n = 0; n < 2; ++n) gn[bj][n] = *(const f32x4*)(g + 32 * bj + 8 * fq + 4 * n); }
#pragma unroll
            for (int ai = 0; ai < 2; ++ai)
#pragma unroll
                for (int m = 0; m < 4; ++m) {
                    int r = u.pm * 256 + ai * 128 + wr * 64 + m * 16 + fr; asm volatile("" : "+v"(r)); const RowInfo ri = row_info(r);
                    f32x4 x[2][2];
#pragma unroll
                    for (int bj = 0; bj < 2; ++bj)
#pragma unroll
                        for (int n = 0; n < 2; ++n) x[bj][n] = acc[ai][bj][m][n];
                    if (isq || isk) {
                        if (isB) { float ss = 0.f;
#pragma unroll
                            for (int bj = 0; bj < 2; ++bj)
#pragma unroll
                                for (int n = 0; n < 2; ++n) ss += (x[bj][n][0] * x[bj][n][0] + x[bj][n][1] * x[bj][n][1]) + (x[bj][n][2] * x[bj][n][2] + x[bj][n][3] * x[bj][n][3]);
                            ss = fq_sum(ss);
                            const float rs = rsqrtf(ss * (1.f / 64.f) + RMS_EPS);
#pragma unroll
                            for (int bj = 0; bj < 2; ++bj)
#pragma unroll
                                for (int n = 0; n < 2; ++n) x[bj][n] = x[bj][n] * rs * gn[bj][n]; }
                        if (lat) { const int pos = fq < 2 ? (ri.t >> 6) : (ri.t & 63); const float2* tb = C.T64 + pos * 16 + 8 * (fq & 1);
#pragma unroll
                            for (int n = 0; n < 2; ++n) { const f32x4 cs0 = *(const f32x4*)(tb + 4 * n), cs1 = *(const f32x4*)(tb + 4 * n + 2);
                                const float cc[4] = {cs0[0], cs0[2], cs1[0], cs1[2]}, sn[4] = {cs0[1], cs0[3], cs1[1], cs1[3]};
#pragma unroll
                                for (int e = 0; e < 4; ++e) { const float x1 = x[0][n][e], x2 = x[1][n][e]; x[0][n][e] = x1 * cc[e] - x2 * sn[e]; x[1][n][e] = x1 * sn[e] + x2 * cc[e]; } } }
                    }
                    if (isq) { bf16* q = (isB ? C.QB() : C.QA()) + (size_t)r * 256 + hh * 64 + 8 * fq;
                        st16(q, pg8::pack8(x[0][0] * C2AB, x[0][1] * C2AB)); st16(q + 32, pg8::pack8(x[1][0] * C2AB, x[1][1] * C2AB)); }
                    else if (isk) { bf16* k = isB ? C.KB(ri.b, hh) : C.KA(ri.b, hh);
                        st16(k + kimg(ri.krow, 8 * fq), pg8::pack8(x[0][0], x[0][1])); st16(k + kimg(ri.krow, 32 + 8 * fq), pg8::pack8(x[1][0], x[1][1])); }
                    else { bf16* v = isB ? C.VB(ri.b, hh) : C.VA(ri.b, hh);
                        st16(v + vimg(ri.krow, 8 * fq), pg8::pack8(x[0][0], x[0][1])); st16(v + vimg(ri.krow, 32 + 8 * fq), pg8::pack8(x[1][0], x[1][1])); }
                    asm volatile("" ::: "memory");
                }
        } else if (tile == 4) {
#pragma unroll
            for (int ai = 0; ai < 2; ++ai)
#pragma unroll
                for (int m = 0; m < 4; ++m) {
                    int r = u.pm * 256 + ai * 128 + wr * 64 + m * 16 + fr; asm volatile("" : "+v"(r)); float ss = 0.f; bf16* o = C.AUP() + (size_t)r * 512 + 32 * wc + 8 * fq;
#pragma unroll
                    for (int bj = 0; bj < 2; ++bj) { const f32x4 a = acc[ai][bj][m][0], b = acc[ai][bj][m][1];
                        ss += (a[0] * a[0] + a[1] * a[1]) + (a[2] * a[2] + a[3] * a[3]) + (b[0] * b[0] + b[1] * b[1]) + (b[2] * b[2] + b[3] * b[3]);
                        st16(o + 128 * bj, pg8::pack8(a, b)); }
                    ss = fq_sum(ss);
                    if (fq == 0) C.SSQ[(size_t)r * 8 + wc] = ss;
                }
        } else {
#pragma unroll
            for (int ai = 0; ai < 2; ++ai)
#pragma unroll
                for (int m = 0; m < 4; ++m) {
                    int r = u.pm * 256 + ai * 128 + wr * 64 + m * 16 + fr; asm volatile("" : "+v"(r)); const RowInfo ri = row_info(r); bf16* o = C.AUP() + (size_t)r * 512 + 256 + 32 * wc + 8 * fq;
                    const f32x4 a = acc[ai][0][m][0], b = acc[ai][0][m][1];
                    float ss = (a[0] * a[0] + a[1] * a[1]) + (a[2] * a[2] + a[3] * a[3]) + (b[0] * b[0] + b[1] * b[1]) + (b[2] * b[2] + b[3] * b[3]);
                    st16(o, pg8::pack8(a, b)); { unsigned z = 0u; asm volatile("" : "+v"(z)); st16(o + 128, (u32x4){z, z, z, z}); }
                    ss = fq_sum(ss);
                    if (fq == 0) C.SSQ[(size_t)r * 8 + 4 + wc] = ss;
                    if (wc == 0) {
                        f32x4 x1 = acc[ai][1][m][0], x2 = acc[ai][1][m][1];
                        if (lat) { const int pos = fq < 2 ? (ri.t >> 6) : (ri.t & 63); const float2* tb = C.T32 + pos * 8 + 4 * (fq & 1);
                            const f32x4 cs0 = *(const f32x4*)(tb), cs1 = *(const f32x4*)(tb + 2); const float cc[4] = {cs0[0], cs0[2], cs1[0], cs1[2]}, sn[4] = {cs0[1], cs0[3], cs1[1], cs1[3]};
#pragma unroll
                            for (int e = 0; e < 4; ++e) { const float p = x1[e], q = x2[e]; x1[e] = p * cc[e] - q * sn[e]; x2[e] = p * sn[e] + q * cc[e]; } }
                        bf16* k = C.KR(ri.b);
                        *(u32x2*)(k + krimg(ri.krow, 4 * fq)) = (u32x2){pg8::cvt_pk_bf16(x1[0], x1[1]), pg8::cvt_pk_bf16(x1[2], x1[3])};
                        *(u32x2*)(k + krimg(ri.krow, 16 + 4 * fq)) = (u32x2){pg8::cvt_pk_bf16(x2[0], x2[1]), pg8::cvt_pk_bf16(x2[2], x2[3])};
                    }
                    asm volatile("" ::: "memory");
                }
        }
    }
};
struct EpiUp {
    static constexpr bool PERM = true;
    Ctx C;
    __device__ __forceinline__ void operator()(const AccT& acc, const pg8::Unit& u, int wr, int wc, int fr, int fq) const {
        const int tile = u.pn; const bool lat = u.pm < ML / 256;
#pragma unroll
        for (int ai = 0; ai < 2; ++ai)
#pragma unroll
            for (int m = 0; m < 4; ++m) {
                int r = u.pm * 256 + ai * 128 + wr * 64 + m * 16 + fr; asm volatile("" : "+v"(r)); const RowInfo ri = row_info(r);
                const f32x4 s0 = *(const f32x4*)(C.SSQ + (size_t)r * 8), s1 = *(const f32x4*)(C.SSQ + (size_t)r * 8 + 4);
                if (tile < 3) {
                    const float sc = rsqrtf(((s0[0] + s0[1]) + (s0[2] + s0[3])) * (1.f / 256.f) + RMS_EPS) * C2C;
                    if (tile < 2) { bf16* q = C.QC() + (size_t)r * 768 + (4 * tile + wc) * 96 + 8 * fq;
                        st16(q, pg8::pack8(acc[ai][0][m][0] * sc, acc[ai][0][m][1] * sc)); st16(q + 32, pg8::pack8(acc[ai][1][m][0] * sc, acc[ai][1][m][1] * sc)); }
                    else { bf16* q = C.QC() + (size_t)r * 768 + (2 * wc + (fq >> 1)) * 96 + 64 + 8 * (fq & 1);
                        const int pos = (fq & 1) == 0 ? (ri.t >> 6) : (ri.t & 63); const float2* tb = C.T32 + pos * 8;
#pragma unroll
                        for (int n = 0; n < 2; ++n) { f32x4 x1 = acc[ai][0][m][n], x2 = acc[ai][1][m][n];
                            if (lat) { const f32x4 cs0 = *(const f32x4*)(tb + 4 * n), cs1 = *(const f32x4*)(tb + 4 * n + 2); const float cc[4] = {cs0[0], cs0[2], cs1[0], cs1[2]}, sn[4] = {cs0[1], cs0[3], cs1[1], cs1[3]};
#pragma unroll
                                for (int e = 0; e < 4; ++e) { const float p = x1[e], qq = x2[e]; x1[e] = p * cc[e] - qq * sn[e]; x2[e] = p * sn[e] + qq * cc[e]; } }
                            x1 = x1 * sc; x2 = x2 * sc;
                            *(u32x2*)(q + 4 * n) = (u32x2){pg8::cvt_pk_bf16(x1[0], x1[1]), pg8::cvt_pk_bf16(x1[2], x1[3])};
                            *(u32x2*)(q + 16 + 4 * n) = (u32x2){pg8::cvt_pk_bf16(x2[0], x2[1]), pg8::cvt_pk_bf16(x2[2], x2[3])};
                            asm volatile("" ::: "memory"); } }
                } else {
                    const float sc = rsqrtf(((s1[0] + s1[1]) + (s1[2] + s1[3])) * (1.f / 128.f) + RMS_EPS);
                    const bool isk = tile < 5; const int h = 4 * ((tile - 3) & 1) + wc; bf16* o = isk ? C.KC(ri.b, h) : C.VC(ri.b, h);
                    const size_t o0 = isk ? kimg(ri.krow, 8 * fq) : vimg(ri.krow, 8 * fq), o1 = isk ? kimg(ri.krow, 32 + 8 * fq) : vimg(ri.krow, 32 + 8 * fq);
                    st16(o + o0, pg8::pack8(acc[ai][0][m][0] * sc, acc[ai][0][m][1] * sc)); st16(o + o1, pg8::pack8(acc[ai][1][m][0] * sc, acc[ai][1][m][1] * sc));
                }
                asm volatile("" ::: "memory");
            }
    }
};
struct EpiRes {
    static constexpr bool PERM = false;
    Ctx C; int which_gate; bool first;
    __device__ __forceinline__ void operator()(const AccT& acc, const pg8::Unit& u, int wr, int wc, int fr, int fq) const {
        const int set = u.pm < 32 ? 0 : (u.pm < 64 ? 1 : 2); const float* g = C.mod(set, which_gate); const int col0 = u.pn * 256 + wc * 32 + 4 * fq;
        f32x4 gv[2][2];
#pragma unroll
        for (int bj = 0; bj < 2; ++bj)
#pragma unroll
            for (int n = 0; n < 2; ++n) gv[bj][n] = *(const f32x4*)(g + col0 + bj * 128 + n * 16);
#pragma unroll
        for (int ai = 0; ai < 2; ++ai)
#pragma unroll
            for (int m = 0; m < 4; ++m) {
                int r = u.pm * 256 + ai * 128 + wr * 64 + m * 16 + fr; asm volatile("" : "+v"(r)); const float* base = (first ? C.resid_in(r) : C.resid(r)) + col0; float* o = C.resid(r) + col0;
#pragma unroll
                for (int bj = 0; bj < 2; ++bj)
#pragma unroll
                    for (int n = 0; n < 2; ++n) { const f32x4 bs = *(const f32x4*)(base + bj * 128 + n * 16); *(f32x4*)(o + bj * 128 + n * 16) = bs * ALPHA + gv[bj][n] * acc[ai][bj][m][n]; }
            }
    }
};
struct EpiRelu2 {
    static constexpr bool PERM = true;
    bf16* O;
    __device__ __forceinline__ void operator()(const AccT& acc, const pg8::Unit& u, int wr, int wc, int fr, int fq) const {
#pragma unroll
        for (int ai = 0; ai < 2; ++ai)
#pragma unroll
            for (int m = 0; m < 4; ++m) { int r = u.pm * 256 + ai * 128 + wr * 64 + m * 16 + fr; asm volatile("" : "+v"(r)); bf16* rowp = O + (size_t)r * DFF + u.pn * 256 + wc * 32 + 8 * fq;
#pragma unroll
                for (int bj = 0; bj < 2; ++bj) { f32x4 a = acc[ai][bj][m][0], b = acc[ai][bj][m][1];
#pragma unroll
                    for (int e = 0; e < 4; ++e) { const float p = fmaxf(a[e], 0.f), q = fmaxf(b[e], 0.f); a[e] = p * p; b[e] = q * q; }
                    st16(rowp + bj * 128, pg8::pack8(a, b)); } }
    }
};

__device__ __forceinline__ int win_src(int n) {
    const int tile = n >> 8, c = n & 255, bj = c >> 7, wc = (c >> 5) & 3, d = 32 * bj + (c & 31);
    switch (tile) {
        case 0: return wc * 64 + d;
        case 1: return (wc < 2 ? 256 + wc * 64 : 384 + (wc - 2) * 64) + d;
        case 2: return 512 + wc * 64 + d;
        case 3: return (wc < 2 ? 768 + wc * 64 : 896 + (wc - 2) * 64) + d;
        case 4: return 1024 + c;
        default: if (c < 128) return 1280 + c; if (c < 160) { const int e = (c - 128) & 7, fq = (c - 128) >> 3; return 1408 + (e < 4 ? 4 * fq + e : 16 + 4 * fq + (e - 4)); } return -1;
    }
}
__device__ __forceinline__ int wuq_src(int n) {
    const int tile = n >> 8, c = n & 255, bj = c >> 7, wc = (c >> 5) & 3, i = c & 31;
    if (tile < 2) return (4 * tile + wc) * 96 + 32 * bj + i;
    return (2 * wc + (i >> 4)) * 96 + 64 + 16 * bj + (i & 15);
}
__device__ __forceinline__ int wukv_src(int n) {
    const int tile = n >> 8, c = n & 255, bj = c >> 7, wc = (c >> 5) & 3, i = c & 31;
    return (4 * tile + wc) * 64 + 32 * bj + i;
}
__device__ __forceinline__ void conv_item(const float* W, int Ks, int Ns, bf16* WT, int Kd, int row_off, int mode, const float* kscale, __attribute__((address_space(3))) float* scr, int kb, int nb, int lane) {
    const int k0 = 64 * kb, n0 = 32 * nb; const int nn = n0 + (lane & 31);
    const int sc = mode == 0 ? nn : mode == 1 ? win_src(nn) : mode == 2 ? wuq_src(nn) : wukv_src(nn);
    float vv[32];
#pragma unroll
    for (int i = 0; i < 32; ++i) { const int k = k0 + 2 * i + (lane >> 5); vv[i] = (sc >= 0 && k < Ks) ? W[(size_t)k * Ns + sc] : 0.f; }
#pragma unroll
    for (int i = 0; i < 32; ++i) { const int kk = 2 * i + (lane >> 5), k = k0 + kk; float v = vv[i]; if (kscale && k < Ks) v *= kscale[k]; scr[kk * 33 + (lane & 31)] = v; }
    asm volatile("s_waitcnt lgkmcnt(0)" ::: "memory");
    const int c = lane & 7;
#pragma unroll
    for (int j = 0; j < 4; ++j) { const int n = (lane >> 3) + 8 * j; const __attribute__((address_space(3))) float* s = scr + (8 * c) * 33 + n;
        u32x4 o; o.x = f2bf(s[0]) | (f2bf(s[33]) << 16); o.y = f2bf(s[66]) | (f2bf(s[99]) << 16); o.z = f2bf(s[132]) | (f2bf(s[165]) << 16); o.w = f2bf(s[198]) | (f2bf(s[231]) << 16);
        *(u32x4*)(WT + (size_t)(row_off + n0 + n) * Kd + k0 + 8 * c) = o; }
    asm volatile("s_waitcnt lgkmcnt(0)" ::: "memory");
}
__device__ __forceinline__ bf16* wts(const Params& p, int l, size_t off) { return (bf16*)(p.ws + WS_W + (size_t)l * W_LAYER + off); }
__device__ __forceinline__ void ph_prologue(const Ctx& C, unsigned char* ldsb) {
    const Params& p = C.p; const int tid = C.tid(), lane = tid & 63, wave = C.wave;
    { float* red = (float*)ldsb;
      float* sil = (float*)ldsb + 2048;
      for (int i = tid; i < 3 * D; i += NTHREADS) sil[i] = nv::silu(i < 2 * D ? p.c[i] : p.c_ctx[i - 2 * D]);
      __syncthreads();
      for (int task = obid(); task < DEPTH * (DMOD / 64); task += ogrid()) {
        const int l = task / (DMOD / 64), n = (task % (DMOD / 64)) * 64 + lane; const float* w = p.w_mod + (size_t)l * D * DMOD + n;
        float a0 = 0.f, a1 = 0.f, a2 = 0.f;
#pragma unroll 32
        for (int kk = 0; kk < 128; ++kk) { const int k = wave * 128 + kk; const float wv = w[(size_t)k * DMOD];
            a0 += sil[k] * wv; a1 += sil[D + k] * wv; a2 += sil[2 * D + k] * wv; }
        __syncthreads();
        red[(wave * 3 + 0) * 64 + lane] = a0; red[(wave * 3 + 1) * 64 + lane] = a1; red[(wave * 3 + 2) * 64 + lane] = a2;
        __syncthreads();
        if (tid < 192) { const int s = tid >> 6; float acc = p.b_mod[l * DMOD + n];
#pragma unroll
            for (int wv = 0; wv < 8; ++wv) acc += red[(wv * 3 + s) * 64 + lane];
            C.MOD[(size_t)(l * 3 + s) * DMOD + n] = acc; }
      }
      __syncthreads();
    }
    const int gtid = obid() * NTHREADS + tid, gsz = ogrid() * NTHREADS;
    for (int idx = gtid; idx < 128 * 16; idx += gsz) { const int pos = idx >> 4, j = idx & 15; const float inv = powf(10000.f, -(float)j / 16.f), a = (float)pos * inv; C.T64[idx] = make_float2(cosf(a), sinf(a)); }
    for (int idx = gtid; idx < 128 * 8; idx += gsz) { const int pos = idx >> 3, j = idx & 7; const float inv = powf(10000.f, -(float)j / 8.f), a = (float)pos * inv; C.T32[idx] = make_float2(cosf(a), sinf(a)); }
    __attribute__((address_space(3))) float* scr = (__attribute__((address_space(3))) float*)(ldsb) + wave * (64 * 33);
    const int gw = obid() * (NTHREADS / 64) + wave, ngw = ogrid() * (NTHREADS / 64);
    constexpr int I_IN = 16 * 48, I_UQ = 4 * 24, I_UKV = 4 * 16, I_OUT = 16 * 32, I_FC1 = 16 * 128, I_FC2 = 64 * 32;
    constexpr int I_L = I_IN + I_UQ + 2 * I_UKV + I_OUT + I_FC1 + I_FC2;
    for (int it = gw; it < DEPTH * I_L; it += ngw) {
        const int l = it / I_L; int r = it % I_L;
        if (r < I_IN) { conv_item(p.w_in + (size_t)l * D * DIN, D, DIN, wts(p, l, W_IN), D, 0, 1, nullptr, scr, r / 48, r % 48, lane); continue; } r -= I_IN;
        if (r < I_UQ) { conv_item(p.w_uq + (size_t)l * 256 * 768, 256, 768, wts(p, l, W_UP), 256, 0, 2, p.mla_q_norm + l * 256, scr, r / 24, r % 24, lane); continue; } r -= I_UQ;
        if (r < I_UKV) { conv_item(p.w_uk + (size_t)l * 128 * 512, 128, 512, wts(p, l, W_UP), 256, 768, 3, p.mla_kv_norm + l * 128, scr, r / 16, r % 16, lane); continue; } r -= I_UKV;
        if (r < I_UKV) { conv_item(p.w_uv + (size_t)l * 128 * 512, 128, 512, wts(p, l, W_UP), 256, 1280, 3, p.mla_kv_norm + l * 128, scr, r / 16, r % 16, lane); continue; } r -= I_UKV;
        if (r < I_OUT) { conv_item(p.w_out + (size_t)l * D * D, D, D, wts(p, l, W_OUT), D, 0, 0, nullptr, scr, r / 32, r % 32, lane); continue; } r -= I_OUT;
        if (r < I_FC1) { conv_item(p.w_fc1 + (size_t)l * D * DFF, D, DFF, wts(p, l, W_FC1), D, 0, 0, nullptr, scr, r / 128, r % 128, lane); continue; } r -= I_FC1;
        conv_item(p.w_fc2 + (size_t)l * DFF * D, DFF, D, wts(p, l, W_FC2), DFF, 0, 0, nullptr, scr, r / 32, r % 32, lane);
    }
}


#define LAS __attribute__((address_space(3)))
constexpr int RING_BYTES = 131072, LDSCTL_OFF = RING_BYTES, MISC_OFF = LDSCTL_OFF + 320, LDS_BYTES = 147456;
constexpr int CW_BAR = 4096;
#define XB_TMO      128
#define XB_XCNT(j)  (256  + 64 * (j))
#define XB_XSUB(j)  (1280 + 64 * (j))
#define XB_XGEN(j)  (2304 + 64 * (j))
#define XB_TOP      3328
#define XB_TOPGEN   3392
#define XB_SPIN_CAP (1u << 20)
__device__ __forceinline__ unsigned xb_ld(unsigned* p)              { return __hip_atomic_load(p, __ATOMIC_RELAXED, __HIP_MEMORY_SCOPE_AGENT); }
__device__ __forceinline__ unsigned xb_add(unsigned* p, unsigned v) { return __hip_atomic_fetch_add(p, v, __ATOMIC_RELAXED, __HIP_MEMORY_SCOPE_AGENT); }
__device__ __forceinline__ unsigned xb_xcc_id() { return (unsigned)__builtin_amdgcn_s_getreg((3 << 11) | 20) & 0xFu; }
#define XB_SPIN(cond, bar) do { unsigned _sp = 0; while (cond) { __builtin_amdgcn_s_sleep(1); \
    if ((++_sp & 255u) == 0u) { if (xb_ld(&(bar)[XB_TMO])) break; if (_sp > XB_SPIN_CAP) { atomicAdd(&(bar)[XB_TMO], 1u); break; } } } } while (0)
struct XcdBarrier { unsigned* bar; unsigned x; volatile LAS unsigned* st; };
__device__ __forceinline__ XcdBarrier xcd_barrier_post(unsigned* bar, volatile LAS unsigned* st, int tid) {
    XcdBarrier b; b.bar = bar; b.x = 0; b.st = st;
    if (tid == 0) (void)xb_add(&bar[XB_XCNT(__builtin_amdgcn_readfirstlane(xb_xcc_id()))], 1u);
    return b;
}
__device__ __forceinline__ void xcd_barrier_complete(unsigned* bar, unsigned x, unsigned& nloc, unsigned& nx) {
    const unsigned G = gridDim.x * gridDim.y * gridDim.z;
    unsigned sum, cnt, mine, sp = 0u;
    for (;;) {
        sum = 0u; cnt = 0u; mine = 0u;
#pragma unroll
        for (unsigned j = 0; j < 16; ++j) { const unsigned c = xb_ld(&bar[XB_XCNT(j)]); sum += c; cnt += (c > 0u) ? 1u : 0u; mine = (j == x) ? c : mine; }
        if (sum == G) break;
        __builtin_amdgcn_s_sleep(1);
        if ((++sp & 255u) == 0u) { if (xb_ld(&bar[XB_TMO])) break; if (sp > XB_SPIN_CAP) { atomicAdd(&bar[XB_TMO], 1u); break; } }
    }
    nloc = mine > 0u ? mine : 1u; nx = cnt > 0u ? cnt : 1u;
}
__device__ __forceinline__ void xcd_barrier(const XcdBarrier& b, int tid) {
    asm volatile("s_waitcnt vmcnt(0)" ::: "memory");
    __syncthreads();
    if (tid == 0) {
        unsigned* bar = b.bar; const unsigned bx = (unsigned)__builtin_amdgcn_readfirstlane(xb_xcc_id());
        __builtin_amdgcn_s_waitcnt(0);
        unsigned nloc = b.st[0], nx = b.st[1];
        if (nloc == 0u) { xcd_barrier_complete(bar, bx, nloc, nx); b.st[0] = nloc; b.st[1] = nx; }
        const unsigned old = xb_add(&bar[XB_XSUB(bx)], 1u);
        const unsigned gen = old / nloc;
        if (old + 1u == (gen + 1u) * nloc) {
            __builtin_amdgcn_fence(__ATOMIC_RELEASE, "agent");
            asm volatile("s_waitcnt vmcnt(0)" ::: "memory");
            const unsigned og = xb_add(&bar[XB_TOP], 1u);
            const unsigned tg = og / nx;
            if (og + 1u == (tg + 1u) * nx) xb_add(&bar[XB_TOPGEN], 1u);
            else XB_SPIN(xb_ld(&bar[XB_TOPGEN]) == tg, bar);
            __builtin_amdgcn_fence(__ATOMIC_ACQUIRE, "agent");
            xb_add(&bar[XB_XGEN(bx)], 1u);
            asm volatile("s_waitcnt vmcnt(0)" ::: "memory");
        } else {
            XB_SPIN(xb_ld(&bar[XB_XGEN(bx)]) == gen, bar);
            __builtin_amdgcn_fence(__ATOMIC_ACQUIRE, "agent");
            asm volatile("s_waitcnt vmcnt(0)" ::: "memory");
        }
    }
    __syncthreads();
}


namespace fa {
typedef short bf16x8 __attribute__((ext_vector_type(8)));
typedef short s16x4 __attribute__((ext_vector_type(4)));
typedef short v4i16_t __attribute__((ext_vector_type(4)));
typedef float f32x16 __attribute__((ext_vector_type(16)));
typedef float f32x2_t __attribute__((ext_vector_type(2))); typedef __bf16 bf16x2_t __attribute__((ext_vector_type(2)));
constexpr int KBUF = 12288, VBUF = 8192, BUFB = KBUF + VBUF, NSLOT = 4, OFF_WS = NSLOT * BUFB, OFF_OST = OFF_WS + 8 * 256, LDS_TOTAL = OFF_OST + 8 * 4096;
static_assert(LDS_TOTAL <= RING_BYTES, "attention LDS");
constexpr float THR = 8.f;
__device__ __forceinline__ int crow(int r, int hi) { return (r & 3) + 8 * (r >> 2) + 4 * hi; }
__device__ __forceinline__ unsigned cvtpk(float lo, float hi) { f32x2_t v = {lo, hi}; bf16x2_t b = __builtin_convertvector(v, bf16x2_t); return __builtin_bit_cast(unsigned, b); }
__device__ __forceinline__ s16x4 vtr(const LAS unsigned char* p) { return __builtin_bit_cast(s16x4, __builtin_amdgcn_ds_read_tr16_b64_v4i16((LAS v4i16_t*)p)); }
__device__ __forceinline__ float max3f(float a, float b, float c) { float r; asm("v_max3_f32 %0, %1, %2, %3" : "=v"(r) : "v"(a), "v"(b), "v"(c)); return r; }
__device__ __forceinline__ float max2f(float a, float b) { float r; asm("v_max_f32_e32 %0, %1, %2" : "=v"(r) : "v"(a), "v"(b)); return r; }
__device__ __forceinline__ float max16(const f32x16& p) { float a, b;
    asm("v_max3_f32 %0, %2, %3, %4\n\tv_max3_f32 %1, %5, %6, %7\n\tv_max3_f32 %0, %0, %8, %9\n\tv_max3_f32 %1, %1, %10, %11\n\tv_max3_f32 %0, %0, %12, %13\n\tv_max3_f32 %1, %1, %14, %15\n\tv_max3_f32 %0, %0, %16, %17\n\tv_max3_f32 %0, %0, %1, %1"
        : "=&v"(a), "=&v"(b) : "v"(p[0]), "v"(p[1]), "v"(p[2]), "v"(p[3]), "v"(p[4]), "v"(p[5]), "v"(p[6]), "v"(p[7]), "v"(p[8]), "v"(p[9]), "v"(p[10]), "v"(p[11]), "v"(p[12]), "v"(p[13]), "v"(p[14]), "v"(p[15]));
    return a; }
__device__ __forceinline__ float swap_max(float m) { float lo, hi; swap32(m, lo, hi); return max2f(lo, hi); }
__device__ __forceinline__ float swap_sum(float m) { float lo, hi; swap32(m, lo, hi); return lo + hi; }
__device__ __forceinline__ void glds16(const void* gbase  , unsigned voff  , unsigned lds_dst  ) { unsigned keep;
    asm volatile("s_mov_b32 %0, m0\n\ts_mov_b32 m0, %3\n\ts_nop 0\n\tglobal_load_lds_dwordx4 %1, %2\n\ts_mov_b32 m0, %0" : "=&s"(keep) : "v"(voff), "s"(gbase), "s"(lds_dst) : "memory"); }
#define FA_BAR() asm volatile("s_waitcnt lgkmcnt(0)\n\ts_barrier" ::: "memory")
#define FA_WAITV(N) asm volatile("s_waitcnt vmcnt(" #N ")" ::: "memory")

template <int DQK, bool MASK>
__device__ __forceinline__ void attn_unit(const Ctx& C, LAS unsigned char* lds, const int tid, const int type, const int b, const int h, const int row0, const int qpos0, const int tlo, const int thi) {
    constexpr int ND0 = DQK / 16;
    const int lane = tid & 63, wid = __builtin_amdgcn_readfirstlane(tid >> 6), r32 = lane & 31, hi = lane >> 5;
    const bool trailing = wid >= 4;
    const int kvh = type == 2 ? h : (h >> 1);
    const bf16* Kimg = type == 0 ? C.KA(b, kvh) : type == 1 ? C.KB(b, kvh) : C.KC(b, kvh);
    const bf16* Vimg = type == 0 ? C.VA(b, kvh) : type == 1 ? C.VB(b, kvh) : C.VC(b, kvh);
    const bf16* KRimg = C.KR(b);
    const int qrow = row0 + wid * 32 + r32;
    const bf16* Q = type == 0 ? C.QA() + (size_t)qrow * 256 + h * 64 : type == 1 ? C.QB() + (size_t)qrow * 256 + h * 64 : C.QC() + (size_t)qrow * 768 + h * 96;
    bf16x8 qr[ND0];
#pragma unroll
    for (int d0 = 0; d0 < ND0; ++d0) qr[d0] = *(const bf16x8*)(Q + 16 * d0 + 8 * hi);
    const int n = 4 + (thi - tlo);
    const unsigned lds0 = (unsigned)(uintptr_t)lds, lane16 = (unsigned)lane * 16u;
    const bf16* kbase_ = Kimg + wid * 512; const bf16* vbase_ = Vimg + wid * 512; const bf16* rbase_ = KRimg + (wid & 3) * 512;
    const unsigned mk_ = lds0 + wid * 1024, mv_ = lds0 + KBUF + wid * 1024, mr_ = lds0 + 8192 + (wid & 3) * 1024;
#define FA_ISSUE(j) do { const int j_ = (j); const int tt_ = j_ < 4 ? j_ : tlo + (j_ - 4); const unsigned so_ = (unsigned)(j_ & 3) * BUFB; const unsigned vo_ = lane16 + (unsigned)tt_ * 8192u; \
        glds16(kbase_, vo_, (unsigned)__builtin_amdgcn_readfirstlane((int)(mk_ + so_))); \
        glds16(vbase_, vo_, (unsigned)__builtin_amdgcn_readfirstlane((int)(mv_ + so_))); \
        if (DQK == 96) glds16(rbase_, lane16 + (unsigned)tt_ * 4096u, (unsigned)__builtin_amdgcn_readfirstlane((int)(mr_ + so_))); } while (0)
#define FA_WAIT_KEEP1() do { if (DQK == 96) FA_WAITV(3); else FA_WAITV(2); } while (0)
    f32x16 o[2]; o[0] = f32x16{}; o[1] = f32x16{};
    float mhat = 0.f, lsum = 0.f;
    f32x16 negm = f32x16{};
    LAS float* wsf = (LAS float*)(lds + OFF_WS) + wid * 64;
    const int koff = hi * 1024 + r32 * 16;
    const int voff = KBUF + ((lane >> 4) & 1) * 32 + (lane & 3) * 8 + (4 * hi + ((lane & 15) >> 2)) * 64;
    const int qpos = qpos0 + wid * 32 + r32;
    constexpr int HD0 = ND0 / 2;
    bf16x8 kfa[2 * HD0], kfb[2 * (ND0 - HD0)]; s16x4 vlo[8], vhh[8]; u32x4 pw[4]; f32x16 p0, p1;
#define FA_LDKA(j) do { const LAS unsigned char* kb_ = lds + ((j) & 3) * BUFB + koff; _Pragma("unroll") for (int d0 = 0; d0 < HD0; ++d0) { kfa[2 * d0] = *(const LAS bf16x8*)(kb_ + d0 * 2048); kfa[2 * d0 + 1] = *(const LAS bf16x8*)(kb_ + d0 * 2048 + 512); } } while (0)
#define FA_LDKB(j) do { const LAS unsigned char* kb_ = lds + ((j) & 3) * BUFB + koff; _Pragma("unroll") for (int d0 = HD0; d0 < ND0; ++d0) { kfb[2 * (d0 - HD0)] = *(const LAS bf16x8*)(kb_ + d0 * 2048); kfb[2 * (d0 - HD0) + 1] = *(const LAS bf16x8*)(kb_ + d0 * 2048 + 512); } } while (0)
#define FA_LDV(j) do { const LAS unsigned char* vb_ = lds + ((j) & 3) * BUFB + voff; _Pragma("unroll") for (int q_ = 0; q_ < 8; ++q_) { vlo[q_] = vtr(vb_ + (q_ >> 2) * 4096 + (q_ & 3) * 1024); vhh[q_] = vtr(vb_ + (q_ >> 2) * 4096 + (q_ & 3) * 1024 + 512); } } while (0)
#define FA_PV() do { _Pragma("unroll") for (int d0 = 0; d0 < 2; ++d0) _Pragma("unroll") for (int ks = 0; ks < 4; ++ks) { const s16x4 lo_ = vlo[d0 * 4 + ks], hh_ = vhh[d0 * 4 + ks]; \
        const bf16x8 vf_ = (bf16x8){lo_[0], lo_[1], lo_[2], lo_[3], hh_[0], hh_[1], hh_[2], hh_[3]}; o[d0] = __builtin_amdgcn_mfma_f32_32x32x16_bf16(__builtin_bit_cast(bf16x8, pw[ks]), vf_, o[d0], 0, 0, 0); } } while (0)
    FA_ISSUE(0); FA_ISSUE(1);
    FA_WAIT_KEEP1();
    FA_BAR();
    if (trailing) { FA_ISSUE(2); FA_WAIT_KEEP1(); FA_BAR(); }
    for (int j = 0; j < n; ++j) {
        if (!trailing) { if (j + 2 < n) FA_ISSUE(j + 2); }
        FA_LDKA(j);
        __builtin_amdgcn_s_setprio(1);
        if (j > 0) FA_PV();
        __builtin_amdgcn_sched_barrier(0);
        FA_LDKB(j);
#pragma unroll
        for (int d0 = 0; d0 < HD0; ++d0) {
            if (d0 == 0) { p0 = __builtin_amdgcn_mfma_f32_32x32x16_bf16(kfa[0], qr[0], negm, 0, 0, 0); p1 = __builtin_amdgcn_mfma_f32_32x32x16_bf16(kfa[1], qr[0], negm, 0, 0, 0); }
            else { p0 = __builtin_amdgcn_mfma_f32_32x32x16_bf16(kfa[2 * d0], qr[d0], p0, 0, 0, 0); p1 = __builtin_amdgcn_mfma_f32_32x32x16_bf16(kfa[2 * d0 + 1], qr[d0], p1, 0, 0, 0); }
        }
#pragma unroll
        for (int d0 = HD0; d0 < ND0; ++d0) {
            p0 = __builtin_amdgcn_mfma_f32_32x32x16_bf16(kfb[2 * (d0 - HD0)], qr[d0], p0, 0, 0, 0); p1 = __builtin_amdgcn_mfma_f32_32x32x16_bf16(kfb[2 * (d0 - HD0) + 1], qr[d0], p1, 0, 0, 0);
        }
        __builtin_amdgcn_s_setprio(0);
        if (!trailing) { if (j + 2 < n) FA_WAIT_KEEP1(); else FA_WAITV(0); }
        FA_BAR();
        if (trailing) { if (j + 3 < n) FA_ISSUE(j + 3); }
        FA_LDV(j);
        const int tcur = j < 4 ? j : tlo + (j - 4);
        if (MASK && tcur >= 4) { const int rel0 = (tcur - 4) * 64 + 4 * hi - qpos;
#pragma unroll
            for (int r = 0; r < 16; ++r) { const int rel = rel0 + (r & 3) + 8 * (r >> 2); if (rel > 128 || rel < -128) p0[r] = -INFINITY; if (rel + 32 > 128 || rel + 32 < -128) p1[r] = -INFINITY; } }
        const float ra = max16(p0), rb = max16(p1);
        const float rm = swap_max(max2f(ra, rb));
        const bool first = (j == 0);
        if (first || __any(rm > THR)) {
            const float dl = first ? rm : max2f(rm, 0.f);
            mhat += dl;
#pragma unroll
            for (int r = 0; r < 16; ++r) { p0[r] -= dl; p1[r] -= dl; }
#pragma unroll
            for (int r = 0; r < 16; ++r) negm[r] = -mhat;
            if (!first) { const float f = __builtin_amdgcn_exp2f(-dl); lsum *= f; if (hi == 0) wsf[r32] = f;
#pragma unroll
                for (int r = 0; r < 16; ++r) { const float fr_ = wsf[crow(r, hi)]; o[0][r] *= fr_; o[1][r] *= fr_; } }
        }
        float sa[4] = {0.f, 0.f, 0.f, 0.f};
#pragma unroll
        for (int r = 0; r < 16; ++r) { p0[r] = __builtin_amdgcn_exp2f(p0[r]); p1[r] = __builtin_amdgcn_exp2f(p1[r]); sa[r & 3] += p0[r] + p1[r]; }
        lsum += (sa[0] + sa[1]) + (sa[2] + sa[3]);
#pragma unroll
        for (int q_ = 0; q_ < 4; ++q_) { pw[0][q_] = cvtpk(p0[2 * q_], p0[2 * q_ + 1]); pw[1][q_] = cvtpk(p0[8 + 2 * q_], p0[9 + 2 * q_]); pw[2][q_] = cvtpk(p1[2 * q_], p1[2 * q_ + 1]); pw[3][q_] = cvtpk(p1[8 + 2 * q_], p1[9 + 2 * q_]); }
        if (trailing) { if (j + 3 < n) FA_WAIT_KEEP1(); else FA_WAITV(0); }
        FA_BAR();
    }
    FA_PV();
    if (!trailing) FA_BAR();
#undef FA_ISSUE
#undef FA_WAIT_KEEP1
#undef FA_LDKA
#undef FA_LDKB
#undef FA_LDV
#undef FA_PV
    float ltot = swap_sum(lsum);
    if (type == 0) ltot += __builtin_amdgcn_exp2f(C.p.sink_a[C.layer * 4 + h] * LOG2E - mhat);
    if (hi == 0) wsf[32 + r32] = 1.f / ltot;
    LAS unsigned short* stg = (LAS unsigned short*)(lds + OFF_OST + wid * 4096);
#pragma unroll
    for (int r = 0; r < 16; ++r) { const int orow = crow(r, hi); const float rl = wsf[32 + orow];
        stg[orow * 64 + r32] = (unsigned short)f2bf(o[0][r] * rl); stg[orow * 64 + 32 + r32] = (unsigned short)f2bf(o[1][r] * rl); }
    bf16* Yw = C.Y() + (size_t)(row0 + wid * 32) * D + (type == 0 ? 0 : type == 1 ? 256 : 512) + h * 64;
#pragma unroll
    for (int i = 0; i < 4; ++i) { const int row = i * 8 + (lane >> 3), ch = lane & 7; const u32x4 v = *(const LAS u32x4*)(stg + row * 64 + ch * 8); *(u32x4*)(Yw + (size_t)row * D + ch * 8) = v; }
    FA_WAITV(0);
    FA_BAR();
}
__device__ __forceinline__ void run_unit(const Ctx& C, LAS unsigned char* lds, int tid, int type, int b, int h, int qb  ) {
    if (qb < 0) { const int row0 = ML + b * CTX;
        if (type == 2) attn_unit<96, false>(C, lds, tid, 2, b, h, row0, 0, 4, 4); else attn_unit<64, false>(C, lds, tid, type, b, h, row0, 0, 4, 4); return; }
    const int q0 = qb * 256, row0 = b * SEQ + q0;
    if (type == 2) attn_unit<96, false>(C, lds, tid, 2, b, h, row0, q0, 4, NTILE);
    else if (type == 1) attn_unit<64, false>(C, lds, tid, 1, b, h, row0, q0, 4, NTILE);
    else { int lo = q0 - 128, hi_ = q0 + 384; if (lo < 0) lo = 0; if (hi_ > SEQ) hi_ = SEQ; attn_unit<64, true>(C, lds, tid, 0, b, h, row0, q0, 4 + lo / 64, 4 + hi_ / 64); }
}
__device__ __forceinline__ void ph_attn(const Ctx& C, LAS unsigned char* lds, int tid, bool with_ctx) {
    const int G = ogrid(), bx = obid();
    const int v = (G % 8 == 0) ? (bx % 8) * (G / 8) + bx / 8 : bx;
    for (int u = v; u < 256; u += G) {
        for (int i = 0; i < 2; ++i) { const int uc = 2 * u + i, pair = uc >> 5; run_unit(C, lds, tid, 2, pair >> 3, pair & 7, uc & 31); }
        run_unit(C, lds, tid, 1, u >> 7, (u >> 5) & 3, u & 31);
        run_unit(C, lds, tid, 0, u >> 7, (u >> 5) & 3, u & 31);
        if (with_ctx && (u & 7) == 0) { const int j = u >> 3;
            if (j < 8) run_unit(C, lds, tid, 0, j >> 2, j & 3, -1); else if (j < 16) run_unit(C, lds, tid, 1, (j - 8) >> 2, j & 3, -1); else run_unit(C, lds, tid, 2, (j - 16) >> 3, j & 7, -1); }
    }
}
}

__device__ __forceinline__ Ctx make_ctx(int layer, int wave) {
    typedef __attribute__((address_space(4))) const unsigned long long kw_t;
    kw_t* kp = (kw_t*)__builtin_amdgcn_kernarg_segment_ptr();
    asm volatile("" : "+s"(kp));
    Ctx C; unsigned long long* d = (unsigned long long*)&C.p;
#pragma unroll
    for (int i = 0; i < (int)(sizeof(Params) / 8); ++i) d[i] = (unsigned long long)(uintptr_t)(void*)(__attribute__((address_space(1))) void*)(uintptr_t)kp[i];
    C.layer = layer; C.wave = wave; unsigned char* ws = C.p.ws;
    C.MOD = (float*)(ws + WS_MOD); C.T64 = (float2*)(ws + WS_T64); C.T32 = (float2*)(ws + WS_T32); C.SSQ = (float*)(ws + WS_SSQ);
    C.RC = (float*)(ws + WS_RC); C.H = (bf16*)(ws + WS_H); C.R = ws + WS_R;
    return C;
}
__global__ void __launch_bounds__(NTHREADS, 2) fwd_kernel(Params p_unused) {
    extern __shared__ __attribute__((aligned(16))) unsigned char lds[];
    cg::grid_group grid = cg::this_grid();
    const int wave_s = __builtin_amdgcn_readfirstlane(threadIdx.x >> 6);
    const int gsz = ogrid() * NTHREADS;
#define TID otid(wave_s)
#define GTID ((int)(obid() * NTHREADS) + otid(wave_s))
#define CTX(l) make_ctx((l), wave_s)
    for (int u = threadIdx.x; u < (LDS_BYTES - LDSCTL_OFF) / 4; u += NTHREADS) ((LAS unsigned*)((LAS unsigned char*)lds + LDSCTL_OFF))[u] = 0u;
    __syncthreads();
    XcdBarrier bar;
    { const Ctx C = CTX(0); bar = xcd_barrier_post((unsigned*)(C.p.ws + WS_CTL) + CW_BAR, (volatile LAS unsigned*)((LAS unsigned char*)lds + MISC_OFF) + 8, TID); }
#define SEAM() xcd_barrier(bar, TID)
#ifndef SKIP_PRO
    { const Ctx C = CTX(0); ph_prologue(C, lds); }
#endif
    grid.sync();
    { const Ctx C = CTX(0); nv::ph_modulate(C, GTID, gsz, MA); }
    SEAM();
    pg8::PG8_LAS_T ring = (pg8::PG8_LAS_T)lds;
    for (int l = 0; l < DEPTH; ++l) {
        const bool last = l == DEPTH - 1; const int nrows = last ? ML : MA;
#ifndef SKIP_IN
        { const Ctx C = CTX(l); pg8::Gemm g{C.H, wts(C.p, l, W_IN), MA, 1536, D, D, 1 << 30, 0}; pg8::StaticOrder S; S.init(MA, 1536, ogrid(), obid()); EpiIn E{C}; pg8::gemm_phase<EpiIn, true>(ring, g, S, E, TID); }
#endif
        SEAM();
#ifndef SKIP_UP
        { const Ctx C = CTX(l); pg8::Gemm g{C.AUP(), wts(C.p, l, W_UP), MA, 1792, 256, 512, 3, 256}; pg8::StaticOrder S; S.init(MA, 1792, ogrid(), obid()); EpiUp E{C}; pg8::gemm_phase<EpiUp, true>(ring, g, S, E, TID); }
#endif
        SEAM();
#ifndef SKIP_ATT
#ifdef NAIVE_ATT
        { const Ctx C = CTX(l); nv::ph_attn(C, (float*)lds, !last); }
#else
        { const Ctx C = CTX(l); fa::ph_attn(C, (LAS unsigned char*)lds, TID, !last); }
#endif
#endif
        SEAM();
#ifndef SKIP_OUT
        { const Ctx C = CTX(l); pg8::Gemm g{C.Y(), wts(C.p, l, W_OUT), nrows, D, D, D, 1 << 30, 0}; pg8::StaticOrder S; S.init(nrows, D, ogrid(), obid()); EpiRes E{C, 2, true}; pg8::gemm_phase<EpiRes, true>(ring, g, S, E, TID); }
#endif
        SEAM();
        { const Ctx C = CTX(l); ph_ln(C, nrows, C.p.ln1_g + l * D, C.p.ln1_b + l * D, true, l, 3, nullptr); }
        SEAM();
#ifndef SKIP_FC1
        { const Ctx C = CTX(l); pg8::Gemm g{C.H, wts(C.p, l, W_FC1), nrows, DFF, D, D, 1 << 30, 0}; pg8::StaticOrder S; S.init(nrows, DFF, ogrid(), obid()); EpiRelu2 E{C.HID()}; pg8::gemm_phase<EpiRelu2, true>(ring, g, S, E, TID); }
#endif
        SEAM();
#ifndef SKIP_FC2
        { const Ctx C = CTX(l); pg8::Gemm g{C.HID(), wts(C.p, l, W_FC2), nrows, D, DFF, DFF, 1 << 30, 0}; pg8::StaticOrder S; S.init(nrows, D, ogrid(), obid()); EpiRes E{C, 5, false}; pg8::gemm_phase<EpiRes, true>(ring, g, S, E, TID); }
#endif
        SEAM();
        { const Ctx C = CTX(l); ph_ln(C, nrows, C.p.ln2_g + l * D, C.p.ln2_b + l * D, !last, l + 1, 0, nullptr); }
        if (!last) SEAM();
    }
    { const Ctx C = CTX(0); if (xb_ld((unsigned*)(C.p.ws + WS_CTL) + CW_BAR + XB_TMO) != 0u) { __syncthreads(); for (int i = GTID; i < ML * D; i += gsz) C.p.out[i] = __builtin_nanf(""); } }
#undef TID
#undef GTID
#undef CTX
#undef SEAM
}

extern "C" void kernel_launch(void* const* d_in, const int* in_sizes, int n_in, void* d_out, int out_size, void* d_ws, size_t ws_size, hipStream_t stream) {
    static int grid = 0;
    if (grid == 0) {
        if (n_in != 22 || out_size != ML * D || ws_size < WS_END) { fprintf(stderr, "kernel_launch: unexpected shapes n_in %d out %d ws %zu (need %zu)\n", n_in, out_size, ws_size, (size_t)WS_END); grid = -1; return; }
        int dev = 0, cus = 0, per_cu = 0;
        hipGetDevice(&dev); hipDeviceGetAttribute(&cus, hipDeviceAttributeMultiprocessorCount, dev);
        hipFuncSetAttribute((const void*)fwd_kernel, hipFuncAttributeMaxDynamicSharedMemorySize, LDS_BYTES);
        hipOccupancyMaxActiveBlocksPerMultiprocessor(&per_cu, (const void*)fwd_kernel, NTHREADS, LDS_BYTES);
        if (per_cu < 1) { fprintf(stderr, "kernel_launch: occupancy query says %d blocks per CU\n", per_cu); grid = -1; return; }
        grid = cus;
    }
    if (grid < 0) return;
    hipMemsetAsync((char*)d_ws + WS_CTL, 0, 1 * MiB, stream);
    Params p{};
    const float** pp = (const float**)&p;
    for (int i = 0; i < 22; ++i) pp[i] = (const float*)d_in[i];
    p.out = (float*)d_out; p.ws = (unsigned char*)d_ws;
    void* args[] = {&p};
    hipError_t e = hipLaunchCooperativeKernel((const void*)fwd_kernel, dim3(grid), dim3(NTHREADS), args, LDS_BYTES, stream);
    if (e != hipSuccess) fprintf(stderr, "cooperative launch failed: %s (grid %d)\n", hipGetErrorString(e), grid);
}
```
